# Optimizing an MI355X kernel written in HIP

```python
import jax, jax.numpy as jnp
from jax import lax
import numpy as np

D_MODEL = 1024
BATCH = 16
SEQ = 2048
DEPTH = 2
DEC_BATCH = 32
DEC_SEQ = 8
PAST_LEN = 16384
PAGE_SIZE = 128

GM_WIDTH = 1024
GM_GROUPS = 8
GM_GROUP_CH = GM_WIDTH // GM_GROUPS
CHUNK = 128
HEAD_DIM = 64
HEADS_PER_GROUP = 8
DIL_CONFIGS = ((128, 1), (512, 4), (2048, 16))
N_DIL = 3
ATT_QKV_WIDTH = N_DIL * HEADS_PER_GROUP * HEAD_DIM
ATT_OUT_WIDTH = HEADS_PER_GROUP * HEAD_DIM
BAND = 128
ROPE_THETA = 10000.0
RMS_EPS = 1e-6
LN_EPS = 1e-5
NEG = -1e30

kernel_name = 'dilated_gmlp_hybrid_step'


def _proj_sizes():
    return (GM_WIDTH, GM_WIDTH, GM_WIDTH, ATT_QKV_WIDTH, ATT_QKV_WIDTH, ATT_QKV_WIDTH,
            ATT_OUT_WIDTH, D_MODEL, D_MODEL)


def split_projection(proj):
    parts, start = [], 0
    for size in _proj_sizes():
        parts.append(proj[..., start:start + size])
        start += size
    return parts


def rms_norm(x, g):
    xf = x.astype(jnp.float32)
    y = xf * lax.rsqrt(jnp.mean(xf * xf, axis=-1, keepdims=True) + RMS_EPS)
    return (y * g.astype(jnp.float32)).astype(x.dtype)


def layer_norm(x, g, b):
    xf = x.astype(jnp.float32)
    mu = jnp.mean(xf, axis=-1, keepdims=True)
    var = jnp.mean(jnp.square(xf - mu), axis=-1, keepdims=True)
    y = (xf - mu) * lax.rsqrt(var + LN_EPS) * g.astype(jnp.float32) + b.astype(jnp.float32)
    return y.astype(x.dtype)


def rope(x, pos):
    half = HEAD_DIM // 2
    inv_freq = ROPE_THETA ** (-jnp.arange(half, dtype=jnp.float32) / half)
    ang = pos.astype(jnp.float32)[:, None] * inv_freq[None, :]
    ang = ang.reshape(ang.shape[:1] + (1,) * (x.ndim - 3) + (half,))
    cos, sin = jnp.cos(ang), jnp.sin(ang)
    xf = x.astype(jnp.float32)
    x1, x2 = xf[..., :half], xf[..., half:]
    return jnp.concatenate([x1 * cos - x2 * sin, x2 * cos + x1 * sin], axis=-1).astype(x.dtype)


def dilated_band_attention(q, k, v, dil, n_back):
    B, S, H, hd = q.shape
    n = S // dil
    nb = -(-n // BAND)
    n_pad = nb * BAND

    def to_sub(a):
        return a.reshape(B, n, dil, H, hd).transpose(0, 2, 1, 3, 4)

    qs = jnp.pad(to_sub(q), ((0, 0), (0, 0), (0, n_pad - n), (0, 0), (0, 0)))
    kv_pad = ((0, 0), (0, 0), (BAND, n_pad - n), (0, 0), (0, 0))
    ks = jnp.pad(to_sub(k), kv_pad)
    vs = jnp.pad(to_sub(v), kv_pad)
    qb = qs.reshape(B, dil, nb, BAND, H, hd)

    def band(a):
        prev = a[:, :, :n_pad].reshape(B, dil, nb, BAND, H, hd)
        cur = a[:, :, BAND:].reshape(B, dil, nb, BAND, H, hd)
        return jnp.concatenate([prev, cur], axis=3)

    kb, vb = band(ks), band(vs)
    s = jnp.einsum('brnqhd,brnkhd->brnhqk', qb, kb,
                   preferred_element_type=jnp.float32) * (HEAD_DIM ** -0.5)
    blk = jnp.arange(nb)[:, None, None]
    qi = jnp.arange(BAND)[None, :, None]
    kj = jnp.arange(2 * BAND)[None, None, :]
    dist = qi + BAND - kj
    key_pos = blk * BAND - BAND + kj
    valid = (dist >= 0) & (dist <= n_back) & (key_pos >= 0)
    s = jnp.where(valid[None, None, :, None], s, NEG)
    lse = jax.nn.logsumexp(s, axis=-1)
    p = jnp.exp(s - lse[..., None])
    o = jnp.einsum('brnhqk,brnkhd->brnqhd', p.astype(vb.dtype), vb,
                   preferred_element_type=jnp.float32)
    o = o.reshape(B, dil, n_pad, H, hd)[:, :, :n].transpose(0, 2, 1, 3, 4).reshape(B, S, H, hd)
    lse = lse.transpose(0, 1, 2, 4, 3).reshape(B, dil, n_pad, H)[:, :, :n]
    lse = lse.transpose(0, 2, 1, 3).reshape(B, S, H)
    return o, lse


def dilated_gather_attention(q, k_all, v_all, dil, n_back):
    T = q.shape[1]
    n_prev = k_all.shape[1] - T
    idx = n_prev + jnp.arange(T)[:, None] - dil * jnp.arange(n_back + 1)[None, :]
    valid = idx >= 0
    idx = jnp.maximum(idx, 0)
    kg = jnp.take(k_all, idx, axis=1)
    vg = jnp.take(v_all, idx, axis=1)
    s = jnp.einsum('bthd,btjhd->bhtj', q, kg,
                   preferred_element_type=jnp.float32) * (HEAD_DIM ** -0.5)
    s = jnp.where(valid[None, None], s, NEG)
    lse = jax.nn.logsumexp(s, axis=-1)
    p = jnp.exp(s - lse[..., None])
    o = jnp.einsum('bhtj,btjhd->bthd', p.astype(vg.dtype), vg,
                   preferred_element_type=jnp.float32)
    return o, lse.transpose(0, 2, 1)


def combine_dilations(outs, lses):
    w = jax.nn.softmax(jnp.stack(lses, axis=0), axis=0)
    return jnp.sum(w[..., None] * jnp.stack(outs, axis=0), axis=0)


def gmlp_spatial_prompt(vn, wm, bs):
    B, S, _ = vn.shape
    vc = vn.reshape(B, S // CHUNK, CHUNK, GM_GROUPS, GM_GROUP_CH)
    y = jnp.einsum('gts,bcsgd->bctgd', wm.astype(vn.dtype), vc) + bs.T[:, :, None].astype(vn.dtype)
    return y.reshape(B, S, GM_WIDTH)


def gmlp_spatial_sample(vn, wm, bs):
    B, T, _ = vn.shape
    vc = vn.reshape(B, T, GM_GROUPS, GM_GROUP_CH)
    y = jnp.einsum('gts,bsgd->btgd', wm[:, :T, :T].astype(vn.dtype), vc) + bs.T[:T, :, None].astype(vn.dtype)
    return y.reshape(B, T, GM_WIDTH)


def mixer_layer(x, c, pos, att_core, gm_spatial, w_ada, b_ada, norm_g, w_in,
                gm_ln_g, gm_ln_b, w_gm_out, w_att_out, w_o):
    Bx, S, _ = x.shape
    mod = jnp.dot(jax.nn.silu(c), w_ada) + b_ada
    shift, scale, gate = jnp.split(mod, 3, axis=-1)
    h = rms_norm(x, norm_g) * (1.0 + scale[:, None]) + shift[:, None]
    u, v, z_a, q, k, val, z_b, g_a, g_b = split_projection(jnp.dot(h, w_in))
    vn = layer_norm(jax.nn.gelu(v), gm_ln_g, gm_ln_b)
    y_a = jax.nn.gelu(u) * gm_spatial(vn) * jax.nn.silu(z_a)
    shp = (Bx, S, N_DIL, HEADS_PER_GROUP, HEAD_DIM)
    q = rope(q.reshape(shp), pos)
    k = rope(k.reshape(shp), pos)
    val = val.reshape(shp)
    y_b = att_core(q, k, val).astype(x.dtype).reshape(Bx, S, ATT_OUT_WIDTH) * jax.nn.silu(z_b)
    merged = (jax.nn.sigmoid(g_a) * jnp.dot(y_a, w_gm_out)
              + jax.nn.sigmoid(g_b) * jnp.dot(y_b, w_att_out))
    x = x + gate[:, None] * jnp.dot(merged, w_o)
    return x, k, val, vn


def setup_inputs(seed: int = 0) -> dict:
    key = jax.random.key(seed)
    ks = jax.random.split(key, 24)
    f32 = jnp.float32

    def nrm(k, shape, scale):
        return scale * jax.random.normal(k, shape, f32)

    in_width = sum(_proj_sizes())
    cshape = lambda win: (DEPTH, DEC_BATCH, min(win, PAST_LEN), 2, HEADS_PER_GROUP, HEAD_DIM)
    return {
        'x_prompt': nrm(ks[0], (BATCH, SEQ, D_MODEL), 1.0),
        'x_sample': nrm(ks[1], (DEC_BATCH, DEC_SEQ, D_MODEL), 1.0),
        'cache_kv_w128': nrm(ks[2], cshape(128), 1.0),
        'cache_kv_w512': nrm(ks[3], cshape(512), 1.0),
        'cache_kv_w2048': nrm(ks[4], cshape(2048), 1.0),
        'c_prompt': nrm(ks[5], (BATCH, D_MODEL), 1.0),
        'c_sample': nrm(ks[6], (DEC_BATCH, D_MODEL), 1.0),
        'w_ada': nrm(ks[7], (DEPTH, D_MODEL, 3 * D_MODEL), 0.5 * D_MODEL ** -0.5),
        'b_ada': nrm(ks[8], (DEPTH, 3 * D_MODEL), 0.01),
        'norm_g': 1.0 + nrm(ks[9], (DEPTH, D_MODEL), 0.05),
        'w_in': nrm(ks[10], (DEPTH, D_MODEL, in_width), D_MODEL ** -0.5),
        'gm_ln_g': 1.0 + nrm(ks[11], (DEPTH, GM_WIDTH), 0.05),
        'gm_ln_b': nrm(ks[12], (DEPTH, GM_WIDTH), 0.02),
        'gm_ws': nrm(ks[13], (DEPTH, GM_GROUPS, CHUNK, CHUNK), CHUNK ** -0.5),
        'gm_bs': 1.0 + nrm(ks[14], (DEPTH, GM_GROUPS, CHUNK), 0.1),
        'w_gm_out': nrm(ks[15], (DEPTH, GM_WIDTH, D_MODEL), GM_WIDTH ** -0.5),
        'w_att_out': nrm(ks[16], (DEPTH, ATT_OUT_WIDTH, D_MODEL), ATT_OUT_WIDTH ** -0.5),
        'w_o': nrm(ks[17], (DEPTH, D_MODEL, D_MODEL), D_MODEL ** -0.5),
        'final_g': 1.0 + nrm(ks[18], (D_MODEL,), 0.05),
    }


def reference(x_prompt, x_sample, cache_kv_w128, cache_kv_w512, cache_kv_w2048,
              c_prompt, c_sample, w_ada, b_ada, norm_g, w_in, gm_ln_g, gm_ln_b,
              gm_ws, gm_bs, w_gm_out, w_att_out, w_o, final_g):
    caches = (cache_kv_w128, cache_kv_w512, cache_kv_w2048)
    S = x_prompt.shape[1]
    T = x_sample.shape[1]
    pos_p = jnp.arange(S, dtype=jnp.int32)
    pos_s = PAST_LEN + jnp.arange(T, dtype=jnp.int32)
    causal = jnp.tril(jnp.ones((CHUNK, CHUNK), dtype=bool))
    xp, xs = x_prompt, x_sample
    new_p = [[] for _ in DIL_CONFIGS]
    new_s = [[] for _ in DIL_CONFIGS]
    gm_v_rows = []
    for l in range(DEPTH):
        wm = jnp.where(causal, gm_ws[l], 0.0)
        bs = gm_bs[l]
        lw = (w_ada[l], b_ada[l], norm_g[l], w_in[l], gm_ln_g[l], gm_ln_b[l],
              w_gm_out[l], w_att_out[l], w_o[l])

        def att_prompt(q, k, v):
            outs, lses = [], []
            for g, (win, dil) in enumerate(DIL_CONFIGS):
                o, lse = dilated_band_attention(q[:, :, g], k[:, :, g], v[:, :, g], dil, win // dil)
                outs.append(o)
                lses.append(lse)
            return combine_dilations(outs, lses)

        def att_sample(q, k, v, layer=l):
            outs, lses = [], []
            for g, (win, dil) in enumerate(DIL_CONFIGS):
                buf = caches[g][layer]
                k_all = jnp.concatenate([buf[:, :, 0], k[:, :, g]], axis=1)
                v_all = jnp.concatenate([buf[:, :, 1], v[:, :, g]], axis=1)
                o, lse = dilated_gather_attention(q[:, :, g], k_all, v_all, dil, win // dil)
                outs.append(o)
                lses.append(lse)
            return combine_dilations(outs, lses)

        xp, kp, vp, _ = mixer_layer(xp, c_prompt, pos_p, att_prompt,
                                    lambda vn: gmlp_spatial_prompt(vn, wm, bs), *lw)
        xs, ks_, vs_, vn_s = mixer_layer(xs, c_sample, pos_s, att_sample,
                                         lambda vn: gmlp_spatial_sample(vn, wm, bs), *lw)
        for g, (win, dil) in enumerate(DIL_CONFIGS):
            n_keep = min(win, S)
            new_p[g].append(jnp.stack([kp[:, S - n_keep:, g], vp[:, S - n_keep:, g]], axis=2))
            new_s[g].append(jnp.stack([ks_[:, :, g], vs_[:, :, g]], axis=2))
        gm_v_rows.append(vn_s)

    y_prompt = rms_norm(xp, final_g)
    y_sample = rms_norm(xs, final_g)
    kv_w128_p = jnp.stack(new_p[0])
    kv_w512_p = jnp.stack(new_p[1])
    kv_w2048_p = jnp.stack(new_p[2])
    kv_w128_s = jnp.stack(new_s[0])
    kv_w512_s = jnp.stack(new_s[1])
    kv_w2048_s = jnp.stack(new_s[2])
    gm_v_s = jnp.stack(gm_v_rows)
    return (y_prompt, y_sample, kv_w128_p, kv_w512_p, kv_w2048_p,
            kv_w128_s, kv_w512_s, kv_w2048_s, gm_v_s)
```

```cpp
#include <hip/hip_runtime.h>
#include <hip/hip_cooperative_groups.h>
#include <cstdio>
#include <cstdint>
#include <cmath>
namespace cg = cooperative_groups;

constexpr int D = 1024, SEQ = 2048, NBATCH = 16, MP = NBATCH * SEQ, DBATCH = 32, TDEC = 8, MS = DBATCH * TDEC, MROWS = MP + MS;
constexpr int NPROJ = 10240, NCOND = 48, PAST = 16384;
constexpr int C_U = 0, C_V = 1024, C_ZA = 2048, C_Q = 3072, C_K = 4608, C_VAL = 6144, C_ZB = 7680, C_GA = 8192, C_GB = 9216;
constexpr size_t O_Y = 0, O_KVP0 = (size_t)MROWS * 1024, O_KVP1 = O_KVP0 + 4194304, O_KVP2 = O_KVP1 + 16777216, O_KVS0 = O_KVP2 + 67108864,
                 O_KVS1 = O_KVS0 + 524288, O_KVS2 = O_KVS1 + 524288, O_GMV = O_KVS2 + 524288, O_TOTAL = O_GMV + 524288;

typedef unsigned short bf16;
typedef float f32x4 __attribute__((ext_vector_type(4)));
typedef float f32x2 __attribute__((ext_vector_type(2)));
typedef unsigned u32x4 __attribute__((ext_vector_type(4)));
typedef unsigned u32x2 __attribute__((ext_vector_type(2)));
#define LAS __attribute__((address_space(3)))

__device__ __forceinline__ float sigmoidf_(float z) { return __builtin_amdgcn_rcpf(1.0f + __builtin_amdgcn_exp2f(-1.4426950408889634f * z)); }
__device__ __forceinline__ float siluf_(float z) { return z * sigmoidf_(z); }
__device__ __forceinline__ float geluf_(float x) { return x * sigmoidf_(1.5957691216057308f * (x + 0.044715f * x * x * x)); }
__device__ __forceinline__ unsigned f2bf(float f) { unsigned u = __builtin_bit_cast(unsigned, f); return (u + 0x7fffu + ((u >> 16) & 1u)) >> 16; }
__device__ __forceinline__ unsigned pk2(float lo, float hi) { return f2bf(lo) | (f2bf(hi) << 16); }
__device__ __forceinline__ float bflo(unsigned w) { return __builtin_bit_cast(float, w << 16); }
__device__ __forceinline__ float bfhi(unsigned w) { return __builtin_bit_cast(float, w & 0xffff0000u); }
__device__ __forceinline__ float bf2f(bf16 b) { return __builtin_bit_cast(float, (unsigned)b << 16); }
__device__ __forceinline__ int cond_row(int m) { return m < MP ? (m >> 11) : NBATCH + ((m - MP) >> 3); }

namespace pg8 {
#define PG8_LAS __attribute__((address_space(3)))
typedef unsigned short bf16_t;
typedef short bf16x8 __attribute__((ext_vector_type(8)));
typedef float f32x4 __attribute__((ext_vector_type(4)));
typedef unsigned u32x4 __attribute__((ext_vector_type(4)));
constexpr int BM = 256, BK = 64, HALF = 128, HTB = HALF * BK * 2  , STAGE_BYTES = 8 * HTB, NXCD = 8, WGM = 8;

__host__ __device__ __forceinline__ int lds_byte(int r, int c) { const int st = (r >> 4) * 2 + (c >> 5), rr = r & 15, cc = c & 31, ob = rr * 64 + cc * 2; return st * 1024 + (ob ^ (((ob >> 9) & 1) << 5)); }
__host__ __device__ __forceinline__ void stage_rc(int b, int& R, int& C) { const int st = b / 1024, sb = b % 1024, swz = sb ^ (((sb >> 9) & 1) << 5); R = (st >> 1) * 16 + swz / 64; C = (st & 1) * 32 + (swz % 64) / 2; }
__host__ __device__ __forceinline__ int perm32(int rho) { const int n = rho >> 4, i = rho & 15; return 8 * (i >> 2) + 4 * n + (i & 3); }

struct Unit { int pm, pn; };
struct Gemm { const bf16_t* A; const bf16_t* Bt; int M, N, K; };

struct StaticOrder {
    int nM, nN, nwg, G, c;
    __host__ __device__ void init(int M, int N, int G_, int c_) { nM = M / BM; nN = N / BM; nwg = nM * nN; G = G_; c = c_; }
    __host__ __device__ bool next(int i, Unit& u) const {
        const long L = (long)i * G + c; if (L >= nwg) return false;
        int wgid = (int)L; { const int q = nwg / NXCD, r = nwg % NXCD, xcd = wgid % NXCD, off = wgid / NXCD; wgid = (xcd < r ? xcd * (q + 1) : r * (q + 1) + (xcd - r) * q) + off; }
        const int nig = WGM * nN, gid = wgid / nig, fm = gid * WGM, gsz = (nM - fm) < WGM ? (nM - fm) : WGM;
        u.pm = fm + ((wgid % nig) % gsz); u.pn = (wgid % nig) / gsz; return true;
    }
    __device__ __forceinline__ void a_ready(const Unit&) const {}
    __device__ __forceinline__ void done(const Unit&) const {}
};

__device__ __forceinline__ unsigned cvt_pk_bf16(float lo, float hi) { unsigned r; asm volatile("v_cvt_pk_bf16_f32 %0, %1, %2" : "=v"(r) : "v"(lo), "v"(hi)); return r; }
typedef float f32x2 __attribute__((ext_vector_type(2)));
struct EpiStoreBf16 {
    static constexpr bool PERM = true, AFTER_DRAIN = false;
    bf16_t* O; int ldc;
    __device__ __forceinline__ void operator()(const f32x4 (&acc)[2][2][4][2], const Unit& u, int wr, int wc, int fr, int fq) const {
        const int row0 = u.pm * BM + wr * 64 + fr, col0 = u.pn * BM + wc * 32 + 8 * fq;
#pragma unroll
        for (int ai = 0; ai < 2; ++ai)
#pragma unroll
            for (int m = 0; m < 4; ++m) { bf16_t* rowp = O + (size_t)(row0 + ai * HALF + m * 16) * ldc + col0;
#pragma unroll
                for (int bj = 0; bj < 2; ++bj) { const f32x4 v0 = acc[ai][bj][m][0], v1 = acc[ai][bj][m][1];
                    u32x4 w; w.x = cvt_pk_bf16(v0[0], v0[1]); w.y = cvt_pk_bf16(v0[2], v0[3]); w.z = cvt_pk_bf16(v1[0], v1[1]); w.w = cvt_pk_bf16(v1[2], v1[3]);
                    *(u32x4*)(rowp + bj * HALF) = w; } }
    }
};
struct EpiGate1 {
    static constexpr bool PERM = false, AFTER_DRAIN = false;
    float* Tq; const bf16_t* G; int ldg;
    __device__ __forceinline__ void operator()(const f32x4 (&acc)[2][2][4][2], const Unit& u, int wr, int wc, int fr, int fq) const {
        const int row0 = u.pm * BM + wr * 64 + fr, col0 = u.pn * BM + wc * 32 + 4 * fq;
#pragma unroll
        for (int ai = 0; ai < 2; ++ai)
#pragma unroll
            for (int m = 0; m < 4; ++m) { const size_t r = (size_t)(row0 + ai * HALF + m * 16);
#pragma unroll
                for (int bj = 0; bj < 2; ++bj)
#pragma unroll
                    for (int n = 0; n < 2; ++n) { const int c = col0 + bj * HALF + n * 16; const u32x2 gw = *(const u32x2*)(G + r * ldg + c);
                        f32x4 o; o[0] = ::sigmoidf_(::bflo(gw.x)) * acc[ai][bj][m][n][0]; o[1] = ::sigmoidf_(::bfhi(gw.x)) * acc[ai][bj][m][n][1];
                        o[2] = ::sigmoidf_(::bflo(gw.y)) * acc[ai][bj][m][n][2]; o[3] = ::sigmoidf_(::bfhi(gw.y)) * acc[ai][bj][m][n][3];
                        *(f32x4*)(Tq + r * 1024 + c) = o; } }
    }
};
struct EpiGate2 {
    static constexpr bool PERM = false, AFTER_DRAIN = false;
    const float* Tq; const bf16_t* G; int ldg; bf16_t* O;
    __device__ __forceinline__ void operator()(const f32x4 (&acc)[2][2][4][2], const Unit& u, int wr, int wc, int fr, int fq) const {
        const int row0 = u.pm * BM + wr * 64 + fr, col0 = u.pn * BM + wc * 32 + 4 * fq;
#pragma unroll
        for (int ai = 0; ai < 2; ++ai)
#pragma unroll
            for (int m = 0; m < 4; ++m) { const size_t r = (size_t)(row0 + ai * HALF + m * 16);
#pragma unroll
                for (int bj = 0; bj < 2; ++bj)
#pragma unroll
                    for (int n = 0; n < 2; ++n) { const int c = col0 + bj * HALF + n * 16; const u32x2 gw = *(const u32x2*)(G + r * ldg + c); const f32x4 t = *(const f32x4*)(Tq + r * 1024 + c);
                        const float o0 = t[0] + ::sigmoidf_(::bflo(gw.x)) * acc[ai][bj][m][n][0], o1 = t[1] + ::sigmoidf_(::bfhi(gw.x)) * acc[ai][bj][m][n][1];
                        const float o2 = t[2] + ::sigmoidf_(::bflo(gw.y)) * acc[ai][bj][m][n][2], o3 = t[3] + ::sigmoidf_(::bfhi(gw.y)) * acc[ai][bj][m][n][3];
                        u32x2 w; w.x = cvt_pk_bf16(o0, o1); w.y = cvt_pk_bf16(o2, o3); *(u32x2*)(O + r * 1024 + c) = w; } }
    }
};
struct EpiResid {
    static constexpr bool PERM = false, AFTER_DRAIN = false;
    const float* xp; const float* xs; const float* gate  ; float* xo;
    __device__ __forceinline__ void operator()(const f32x4 (&acc)[2][2][4][2], const Unit& u, int wr, int wc, int fr, int fq) const {
        const int row0 = u.pm * BM + wr * 64 + fr, col0 = u.pn * BM + wc * 32 + 4 * fq;
#pragma unroll
        for (int ai = 0; ai < 2; ++ai)
#pragma unroll
            for (int m = 0; m < 4; ++m) { const int r = row0 + ai * HALF + m * 16; const float* xr = r < ::MP ? xp + (size_t)r * 1024 : xs + (size_t)(r - ::MP) * 1024;
                const float* gr = gate + (size_t)::cond_row(r) * 3072;
#pragma unroll
                for (int bj = 0; bj < 2; ++bj)
#pragma unroll
                    for (int n = 0; n < 2; ++n) { const int c = col0 + bj * HALF + n * 16; const f32x4 xv = *(const f32x4*)(xr + c), gv = *(const f32x4*)(gr + c);
                        *(f32x4*)(xo + (size_t)r * 1024 + c) = xv + gv * acc[ai][bj][m][n]; } }
    }
};
template <class Epi, class Sched, bool ALIGN_EPI = false, bool SP2 = false>
__device__ __forceinline__ void gemm_phase(PG8_LAS unsigned char* lds, const Gemm g, const Sched& S, const Epi& E) {
    int tid_ = threadIdx.x; asm volatile("" : "+v"(tid_));
    const int tid = tid_, wid = __builtin_amdgcn_readfirstlane(tid >> 6), lane = tid & 63, wr = wid >> 2, wc = wid & 3, fr = lane & 15, fq = lane >> 4;
    const int K = g.K, nt = K / BK;
    unsigned voffA[2], voffB[2];
#pragma unroll
    for (int i = 0; i < 2; ++i) { int R, C; stage_rc(tid * 16 + i * 8192, R, C); const int Rb = Epi::PERM ? ((R & ~31) + perm32(R & 31)) : R;
        voffA[i] = (unsigned)(R * K + C) * 2u; voffB[i] = (unsigned)(Rb * K + C) * 2u; }
    const size_t kstep = (size_t)(BK * 2);
    const size_t hstep = (size_t)HALF * K * 2;
    const size_t tstep = 2 * hstep;
    const unsigned ldsw = (unsigned)wid * 1024u;
    const int aoff = lds_byte(wr * 64 + fr, fq * 8), boff = lds_byte(wc * 32 + fr, fq * 8);
#define PG8_SA(b, h) (((b) * 2 + (h)) * HTB)
#define PG8_SB(b, h) ((4 + (b) * 2 + (h)) * HTB)
#define PG8_STAGE(bufoff, gbase, voff) do { _Pragma("unroll") for (int _i = 0; _i < 2; ++_i) \
        __builtin_amdgcn_global_load_lds((const unsigned*)((const char*)(gbase) + (voff)[_i]), (PG8_LAS unsigned*)(lds + (bufoff) + ldsw + _i * 8192), 16, 0, 0); } while (0)
#define PG8_LDA(dst, b, h) do { _Pragma("unroll") for (int m = 0; m < 4; ++m) _Pragma("unroll") for (int k = 0; k < 2; ++k) dst[m][k] = *(const PG8_LAS bf16x8*)(lds + PG8_SA(b, h) + aoff + m * 2048 + k * 1024); } while (0)
#define PG8_LDB(dst, b, h) do { _Pragma("unroll") for (int n = 0; n < 2; ++n) _Pragma("unroll") for (int k = 0; k < 2; ++k) dst[n][k] = *(const PG8_LAS bf16x8*)(lds + PG8_SB(b, h) + boff + n * 2048 + k * 1024); } while (0)
#define PG8_MMA(ai, bj, At, Bt) do { __builtin_amdgcn_s_setprio(1); _Pragma("unroll") for (int m = 0; m < 4; ++m) _Pragma("unroll") for (int n = 0; n < 2; ++n) _Pragma("unroll") for (int k = 0; k < 2; ++k) \
        acc[ai][bj][m][n] = __builtin_amdgcn_mfma_f32_16x16x32_bf16(Bt[n][k], At[m][k], acc[ai][bj][m][n], 0, 0, 0); __builtin_amdgcn_s_setprio(0); } while (0)
#define PG8_WAIT_V(n) asm volatile("s_waitcnt vmcnt(" #n ")" ::: "memory")
#define PG8_WAIT_L(n) asm volatile("s_waitcnt lgkmcnt(" #n ")" ::: "memory")
#define PG8_BAR __builtin_amdgcn_s_barrier()
#define PG8_SCHED __builtin_amdgcn_sched_barrier(0)
    Unit cur, nxt; int ui = 0;
    if (!S.next(0, cur)) return;
    f32x4 acc[2][2][4][2];
#pragma unroll
    for (int a = 0; a < 2; ++a)
#pragma unroll
        for (int b = 0; b < 2; ++b)
#pragma unroll
            for (int m = 0; m < 4; ++m)
#pragma unroll
                for (int n = 0; n < 2; ++n) acc[a][b][m][n] = (f32x4){0.f, 0.f, 0.f, 0.f};
    bf16x8 At[4][2], B0[2][2], B1[2][2];
    const char* cA = (const char*)g.A + (size_t)cur.pm * tstep; const char* cB = (const char*)g.Bt + (size_t)cur.pn * tstep;
    S.a_ready(cur);
    if constexpr (SP2) {
        PG8_STAGE(PG8_SB(0, 0), cB, voffB); PG8_STAGE(PG8_SB(0, 1), cB + hstep, voffB); PG8_STAGE(PG8_SA(0, 0), cA, voffA); PG8_STAGE(PG8_SA(0, 1), cA + hstep, voffA);
        if (wr == 1) PG8_BAR;
        PG8_WAIT_V(2); PG8_BAR;
        PG8_STAGE(PG8_SB(1, 0), cB + kstep, voffB); PG8_STAGE(PG8_SA(1, 0), cA + kstep, voffA); PG8_STAGE(PG8_SB(1, 1), cB + hstep + kstep, voffB);
        PG8_WAIT_V(6); PG8_BAR;
    } else {
        PG8_STAGE(PG8_SB(0, 0), cB, voffB); PG8_STAGE(PG8_SA(0, 0), cA, voffA); PG8_STAGE(PG8_SB(0, 1), cB + hstep, voffB); PG8_STAGE(PG8_SA(0, 1), cA + hstep, voffA);
        if (wr == 1) PG8_BAR;
        PG8_WAIT_V(4); PG8_BAR;
        PG8_STAGE(PG8_SB(1, 0), cB + kstep, voffB); PG8_STAGE(PG8_SA(1, 0), cA + kstep, voffA); PG8_STAGE(PG8_SB(1, 1), cB + hstep + kstep, voffB);
        PG8_WAIT_V(6); PG8_BAR;
    }
    for (;;) {
        const bool has_next = S.next(ui + 1, nxt);
        const char* nA = has_next ? (const char*)g.A + (size_t)nxt.pm * tstep : cA; const char* nB = has_next ? (const char*)g.Bt + (size_t)nxt.pn * tstep : cB;
        for (int t = 0; t < nt; t += 2) {
            const bool last = (t == nt - 2);
            const char* a1 = cA + (size_t)(t + 1) * kstep;
            const char* a2 = last ? nA : cA + (size_t)(t + 2) * kstep; const char* b2 = last ? nB : cB + (size_t)(t + 2) * kstep;
            const char* a3 = a2 + kstep; const char* b3 = b2 + kstep;
            if (last && has_next) S.a_ready(nxt);
            if constexpr (SP2) {
            PG8_LDB(B0, 0, 0); PG8_LDB(B1, 0, 1); PG8_SCHED; PG8_LDA(At, 0, 0); PG8_STAGE(PG8_SA(1, 1), a1 + hstep, voffA);
            PG8_WAIT_V(8); PG8_WAIT_L(0); PG8_BAR; PG8_MMA(0, 0, At, B0); PG8_MMA(0, 1, At, B1); PG8_BAR; PG8_SCHED;
            PG8_LDA(At, 0, 1); PG8_STAGE(PG8_SB(0, 0), b2, voffB); PG8_STAGE(PG8_SB(0, 1), b2 + hstep, voffB); PG8_STAGE(PG8_SA(0, 0), a2, voffA);
            PG8_WAIT_V(8); PG8_WAIT_L(0); PG8_BAR; PG8_MMA(1, 0, At, B0); PG8_MMA(1, 1, At, B1); PG8_BAR; PG8_SCHED;
            PG8_LDB(B0, 1, 0); PG8_LDB(B1, 1, 1); PG8_SCHED; PG8_LDA(At, 1, 0); PG8_STAGE(PG8_SA(0, 1), a2 + hstep, voffA);
            PG8_WAIT_V(8); PG8_WAIT_L(0); PG8_BAR; PG8_MMA(0, 0, At, B0); PG8_MMA(0, 1, At, B1); PG8_BAR; PG8_SCHED;
            PG8_LDA(At, 1, 1); PG8_STAGE(PG8_SB(1, 0), b3, voffB); PG8_STAGE(PG8_SB(1, 1), b3 + hstep, voffB); PG8_STAGE(PG8_SA(1, 0), a3, voffA);
            PG8_WAIT_V(8); PG8_WAIT_L(0); PG8_BAR; PG8_MMA(1, 0, At, B0); PG8_MMA(1, 1, At, B1); PG8_BAR; PG8_SCHED;
            } else {
            PG8_LDB(B0, 0, 0); PG8_SCHED; PG8_LDA(At, 0, 0); PG8_STAGE(PG8_SA(1, 1), a1 + hstep, voffA);
            PG8_WAIT_L(8); PG8_BAR; PG8_WAIT_L(0); PG8_MMA(0, 0, At, B0); PG8_BAR; PG8_SCHED;
            PG8_LDB(B1, 0, 1); PG8_STAGE(PG8_SB(0, 0), b2, voffB);
            PG8_BAR; PG8_WAIT_L(0); PG8_MMA(0, 1, At, B1); PG8_BAR;
            PG8_LDA(At, 0, 1); PG8_STAGE(PG8_SA(0, 0), a2, voffA);
            PG8_BAR; PG8_WAIT_L(0); PG8_MMA(1, 0, At, B0); PG8_BAR; PG8_SCHED;
            PG8_STAGE(PG8_SB(0, 1), b2 + hstep, voffB);
            PG8_WAIT_V(6); PG8_BAR; PG8_MMA(1, 1, At, B1); PG8_BAR;
            PG8_LDB(B0, 1, 0); PG8_SCHED; PG8_LDA(At, 1, 0); PG8_STAGE(PG8_SA(0, 1), a2 + hstep, voffA);
            PG8_WAIT_L(8); PG8_BAR; PG8_WAIT_L(0); PG8_MMA(0, 0, At, B0); PG8_BAR; PG8_SCHED;
            PG8_LDB(B1, 1, 1); PG8_STAGE(PG8_SB(1, 0), b3, voffB);
            PG8_BAR; PG8_WAIT_L(0); PG8_MMA(0, 1, At, B1); PG8_BAR;
            PG8_LDA(At, 1, 1); PG8_STAGE(PG8_SA(1, 0), a3, voffA);
            PG8_BAR; PG8_WAIT_L(0); PG8_MMA(1, 0, At, B0); PG8_BAR; PG8_SCHED;
            PG8_STAGE(PG8_SB(1, 1), b3 + hstep, voffB);
            PG8_WAIT_V(6); PG8_BAR; PG8_MMA(1, 1, At, B1); PG8_BAR;
            }
        }
        if constexpr (ALIGN_EPI) { if (wr == 0) PG8_BAR; }
        if constexpr (!Epi::AFTER_DRAIN) { E(acc, cur, wr, wc, fr, fq); S.done(cur); }
        if (!has_next) break;
#pragma unroll
        for (int a = 0; a < 2; ++a)
#pragma unroll
            for (int b = 0; b < 2; ++b)
#pragma unroll
                for (int m = 0; m < 4; ++m)
#pragma unroll
                    for (int n = 0; n < 2; ++n) acc[a][b][m][n] = (f32x4){0.f, 0.f, 0.f, 0.f};
        cur = nxt; cA = nA; cB = nB; ++ui;
        if constexpr (ALIGN_EPI) { if (wr == 1) PG8_BAR; }
    }
    PG8_WAIT_V(0);
    if constexpr (!ALIGN_EPI) { if (wr == 0) PG8_BAR; }
    PG8_BAR;
    if constexpr (Epi::AFTER_DRAIN) { E.fused(acc, cur, wr, wc, fr, fq, lds, wid, lane); S.done(cur); }
#undef PG8_SA
#undef PG8_SB
#undef PG8_STAGE
#undef PG8_LDA
#undef PG8_LDB
#undef PG8_MMA
#undef PG8_WAIT_V
#undef PG8_WAIT_L
#undef PG8_BAR
#undef PG8_SCHED
}
}

constexpr size_t MiB = 1u << 20;
constexpr size_t WS_MOD = 1 * MiB, WS_ROPE = 3 * MiB, WS_WTIN = 4 * MiB, WS_WTGM = 44 * MiB, WS_WTATT = 48 * MiB, WS_WTO = 50 * MiB,
                 WS_H = 56 * MiB, WS_YA = 122 * MiB, WS_YB = 188 * MiB, WS_OG = 222 * MiB, WS_LSE = 320 * MiB, WS_MERGED = 324 * MiB,
                 WS_T = 390 * MiB, WS_X = 520 * MiB, WS_PROJ = 650 * MiB, WS_END = 1296 * MiB;
constexpr size_t OG_STRIDE = (size_t)MROWS * 512;
constexpr size_t LSE_STRIDE = (size_t)MROWS * 8;
constexpr int LDS_BYTES = 147456;
constexpr int NTHREADS = 512;

struct Args {
    const float* x_prompt; const float* x_sample; const float* cache0; const float* cache1; const float* cache2; const float* c_prompt; const float* c_sample;
    const float* w_ada; const float* b_ada; const float* norm_g; const float* w_in; const float* gm_ln_g; const float* gm_ln_b; const float* gm_ws; const float* gm_bs;
    const float* w_gm_out; const float* w_att_out; const float* w_o; const float* final_g;
    float* out; unsigned char* ws;
};
constexpr int PTAB_OFF = 131072 + 1024;
struct PT {
    LAS const unsigned long long* t;
    __device__ __forceinline__ unsigned long long g(int i) const { const unsigned long long v = t[i]; const unsigned lo = __builtin_amdgcn_readfirstlane((unsigned)v), hi = __builtin_amdgcn_readfirstlane((unsigned)(v >> 32)); return ((unsigned long long)hi << 32) | lo; }
#define GASP(v) ((__attribute__((address_space(1))) unsigned char*)(v))
#define PTF(name, idx) __device__ __forceinline__ const float* name() const { return (const float*)GASP(g(idx)); }
    PTF(x_prompt, 0) PTF(x_sample, 1) PTF(cache0, 2) PTF(cache1, 3) PTF(cache2, 4) PTF(c_prompt, 5) PTF(c_sample, 6) PTF(w_ada, 7) PTF(b_ada, 8) PTF(norm_g, 9) PTF(w_in, 10)
    PTF(gm_ln_g, 11) PTF(gm_ln_b, 12) PTF(gm_ws, 13) PTF(gm_bs, 14) PTF(w_gm_out, 15) PTF(w_att_out, 16) PTF(w_o, 17) PTF(final_g, 18)
#undef PTF
    __device__ __forceinline__ float* out() const { return (float*)GASP(g(19)); }
    __device__ __forceinline__ unsigned char* ws() const { return (unsigned char*)GASP(g(20)); }
};
__device__ const float INV_FREQ[32] = {1.000000000e+00f, 7.498942614e-01f, 5.623413324e-01f, 4.216965139e-01f, 3.162277639e-01f, 2.371373773e-01f, 1.778279394e-01f, 1.333521307e-01f, 1.000000015e-01f, 7.498941571e-02f, 5.623413250e-02f, 4.216965288e-02f, 3.162277490e-02f, 2.371373773e-02f, 1.778279431e-02f, 1.333521493e-02f, 9.999999776e-03f, 7.498941850e-03f, 5.623413250e-03f, 4.216964822e-03f, 3.162277630e-03f, 2.371373586e-03f, 1.778279431e-03f, 1.333521446e-03f, 1.000000047e-03f, 7.498942432e-04f, 5.623413017e-04f, 4.216965172e-04f, 3.162277571e-04f, 2.371373703e-04f, 1.778279402e-04f, 1.333521504e-04f};

__device__ __forceinline__ float wave_sum(float v) {
#pragma unroll
    for (int o = 1; o < 64; o <<= 1) v += __shfl_xor(v, o);
    return v;
}

__device__ __forceinline__ void p0_transpose_item(const float* W, int K, int N, bf16* WT, LAS float* scr, int item, int lane) {
    const int nblk = N / 32, kb = item / nblk, nb = item % nblk, k0 = 64 * kb, n0 = 32 * nb;
#pragma unroll 8
    for (int i = 0; i < 32; ++i) { const int kk = 2 * i + (lane >> 5); scr[kk * 33 + (lane & 31)] = W[(size_t)(k0 + kk) * N + n0 + (lane & 31)]; }
    asm volatile("s_waitcnt lgkmcnt(0)" ::: "memory");
    const int c = lane & 7;
#pragma unroll
    for (int j = 0; j < 4; ++j) { const int n = (lane >> 3) + 8 * j; const LAS float* s = scr + (8 * c) * 33 + n;
        u32x4 o; o.x = pk2(s[0 * 33], s[1 * 33]); o.y = pk2(s[2 * 33], s[3 * 33]); o.z = pk2(s[4 * 33], s[5 * 33]); o.w = pk2(s[6 * 33], s[7 * 33]);
        *(u32x4*)(WT + (size_t)(n0 + n) * K + k0 + 8 * c) = o; }
    asm volatile("s_waitcnt lgkmcnt(0)" ::: "memory");
}

__device__ __forceinline__ void p0_mod_item(const PT& a, LAS unsigned char* lds, int item, int tid) {
    const float* c_prompt_ = a.c_prompt(); const float* c_sample_ = a.c_sample(); const float* w_ada_ = a.w_ada(); const float* b_ada_ = a.b_ada(); unsigned char* ws_ = a.ws();
    const int wave = tid >> 6, lane = tid & 63;
    const int rg = item % 3; const int r2 = item / 3; const int cb = r2 % 48; const int l = r2 / 48;
    const int row0 = rg * 16, col = cb * 64 + lane, k0 = wave * 128;
    LAS float* tab = (LAS float*)(lds + wave * 8192);
    for (int e = lane; e < 2048; e += 64) { const int rr = e >> 7, kk = e & 127; const int cr = row0 + rr;
        const float* cp = cr < NBATCH ? c_prompt_ + (size_t)cr * 1024 : c_sample_ + (size_t)(cr - NBATCH) * 1024; tab[e] = siluf_(cp[k0 + kk]); }
    asm volatile("s_waitcnt lgkmcnt(0)" ::: "memory");
    float acc[16];
#pragma unroll
    for (int r = 0; r < 16; ++r) acc[r] = 0.f;
    const float* wp = w_ada_ + (size_t)l * 1024 * 3072 + (size_t)k0 * 3072 + col;
#pragma unroll 2
    for (int kk = 0; kk < 128; kk += 4) {
        const float w0 = wp[(size_t)(kk + 0) * 3072], w1 = wp[(size_t)(kk + 1) * 3072], w2 = wp[(size_t)(kk + 2) * 3072], w3 = wp[(size_t)(kk + 3) * 3072];
#pragma unroll
        for (int r = 0; r < 16; ++r) { const f32x4 t = *(const LAS f32x4*)(tab + r * 128 + kk); acc[r] += (t[0] * w0 + t[1] * w1) + (t[2] * w2 + t[3] * w3); }
    }
    LAS float* red = (LAS float*)(lds + 65536);
#pragma unroll
    for (int r = 0; r < 16; ++r) red[(wave * 16 + r) * 64 + lane] = acc[r];
    __syncthreads();
    float* mod = (float*)(ws_ + WS_MOD);
    for (int e = tid; e < 1024; e += NTHREADS) { const int rr = e >> 6, cc = e & 63; float s = 0.f;
#pragma unroll
        for (int w = 0; w < 8; ++w) s += red[(w * 16 + rr) * 64 + cc];
        const int colg = cb * 64 + cc; mod[((size_t)l * NCOND + row0 + rr) * 3072 + colg] = s + b_ada_[l * 3072 + colg]; }
    __syncthreads();
}

__device__ __forceinline__ void p0_phase(const PT& a, LAS unsigned char* lds, int tid, int bid, int G) {
    const float* w_in_ = a.w_in(); const float* w_gm_out_ = a.w_gm_out(); const float* w_att_out_ = a.w_att_out(); const float* w_o_ = a.w_o(); unsigned char* ws_ = a.ws();
    const int wave = tid >> 6, lane = tid & 63;
    for (int it = bid; it < 288; it += G) p0_mod_item(a, lds, it, tid);
    { f32x2* rt = (f32x2*)(ws_ + WS_ROPE);
      for (int e = bid * NTHREADS + tid; e < 2056 * 32; e += G * NTHREADS) { const int pi = e >> 5, i = e & 31; const int pos = pi < SEQ ? pi : PAST + (pi - SEQ);
          const float ang = (float)pos * INV_FREQ[i]; const double rv = (double)ang * 0.15915494309189535; const float f = (float)(rv - rint(rv));
          f32x2 cs; cs.x = __builtin_amdgcn_cosf(f); cs.y = __builtin_amdgcn_sinf(f); rt[e] = cs; } }
    LAS float* scr = (LAS float*)(lds + wave * 16384);
    const int gw = bid * 8 + wave, NGW = G * 8;
    constexpr int I_IN = 16 * 320, I_GM = 16 * 32, I_ATT = 8 * 32, I_O = 16 * 32, I_L = I_IN + I_GM + I_ATT + I_O;
    for (int it = gw; it < 2 * I_L; it += NGW) {
        const int l = it / I_L; int r = it % I_L;
        if (r < I_IN) { p0_transpose_item(w_in_ + (size_t)l * 1024 * NPROJ, 1024, NPROJ, (bf16*)(ws_ + WS_WTIN) + (size_t)l * NPROJ * 1024, scr, r, lane); continue; } r -= I_IN;
        if (r < I_GM) { p0_transpose_item(w_gm_out_ + (size_t)l * 1024 * 1024, 1024, 1024, (bf16*)(ws_ + WS_WTGM) + (size_t)l * 1024 * 1024, scr, r, lane); continue; } r -= I_GM;
        if (r < I_ATT) { p0_transpose_item(w_att_out_ + (size_t)l * 512 * 1024, 512, 1024, (bf16*)(ws_ + WS_WTATT) + (size_t)l * 1024 * 512, scr, r, lane); continue; } r -= I_ATT;
        p0_transpose_item(w_o_ + (size_t)l * 1024 * 1024, 1024, 1024, (bf16*)(ws_ + WS_WTO) + (size_t)l * 1024 * 1024, scr, r, lane);
    }
}

__device__ __forceinline__ void norm_phase(const PT& a, int l  , const float* xbuf  , int tid, int bid, int G) {
    const float* x_prompt_ = a.x_prompt(); const float* x_sample_ = a.x_sample(); const float* norm_g_ = a.norm_g(); const float* final_g_ = a.final_g(); float* out_ = a.out(); unsigned char* ws_ = a.ws();
    const int wave = tid >> 6, lane = tid & 63; const int gw = bid * 8 + wave, NGW = G * 8;
    const float* mod = (const float*)(ws_ + WS_MOD);
    bf16* H = (bf16*)(ws_ + WS_H);
    for (int m = gw; m < MROWS; m += NGW) {
        const float* xr = xbuf ? xbuf + (size_t)m * 1024 : (m < MP ? x_prompt_ + (size_t)m * 1024 : x_sample_ + (size_t)(m - MP) * 1024);
        f32x4 v[4]; float ss = 0.f;
#pragma unroll
        for (int j = 0; j < 4; ++j) { v[j] = *(const f32x4*)(xr + 4 * lane + 256 * j); ss += (v[j][0] * v[j][0] + v[j][1] * v[j][1]) + (v[j][2] * v[j][2] + v[j][3] * v[j][3]); }
        const float rstd = 1.0f / sqrtf(wave_sum(ss) * (1.0f / 1024.0f) + 1e-6f);
        if (l < 2) {
            const float* mr = mod + ((size_t)l * NCOND + cond_row(m)) * 3072;
#pragma unroll
            for (int j = 0; j < 4; ++j) { const int c = 4 * lane + 256 * j; const f32x4 g = *(const f32x4*)(norm_g_ + l * 1024 + c), sh = *(const f32x4*)(mr + c), sc = *(const f32x4*)(mr + 1024 + c);
                const f32x4 h = (v[j] * rstd) * g * (sc + 1.0f) + sh; u32x2 w; w.x = pk2(h[0], h[1]); w.y = pk2(h[2], h[3]); *(u32x2*)(H + (size_t)m * 1024 + c) = w; }
        } else {
#pragma unroll
            for (int j = 0; j < 4; ++j) { const int c = 4 * lane + 256 * j; const f32x4 g = *(const f32x4*)(final_g_ + c); *(f32x4*)(out_ + O_Y + (size_t)m * 1024 + c) = (v[j] * rstd) * g; }
        }
    }
}

__device__ __forceinline__ float* kv_out_ptr(float* out_, int l, int m, int g, int kvsel) {
    if (m >= MP) { const int r = m - MP; const size_t off = (g == 0 ? O_KVS0 : g == 1 ? O_KVS1 : O_KVS2); return out_ + off + (((size_t)l * MS + r) * 2 + kvsel) * 512; }
    const int b = m >> 11, t = m & 2047; const int nk = g == 0 ? 128 : g == 1 ? 512 : 2048; const int i = t - (SEQ - nk); if (i < 0) return nullptr;
    const size_t off = (g == 0 ? O_KVP0 : g == 1 ? O_KVP1 : O_KVP2); return out_ + off + ((((size_t)l * NBATCH + b) * nk + i) * 2 + kvsel) * 512;
}
__device__ __forceinline__ void p2a_phase(const PT& a, int l, int tid, int bid, int G) {
    const float* gm_ln_g_ = a.gm_ln_g(); const float* gm_ln_b_ = a.gm_ln_b(); float* out_ = a.out(); unsigned char* ws_ = a.ws();
    const int wave = tid >> 6, lane = tid & 63; const int gw = bid * 8 + wave, NGW = G * 8;
    bf16* P = (bf16*)(ws_ + WS_PROJ);
    const f32x2* rt = (const f32x2*)(ws_ + WS_ROPE);
    for (int m = gw; m < MROWS; m += NGW) {
        bf16* pr = P + (size_t)m * NPROJ;
        { float gv[16]; float s = 0.f;
#pragma unroll
          for (int j = 0; j < 2; ++j) { const u32x4 w = *(const u32x4*)(pr + C_V + 8 * lane + 512 * j);
              gv[8 * j + 0] = geluf_(bflo(w.x)); gv[8 * j + 1] = geluf_(bfhi(w.x)); gv[8 * j + 2] = geluf_(bflo(w.y)); gv[8 * j + 3] = geluf_(bfhi(w.y));
              gv[8 * j + 4] = geluf_(bflo(w.z)); gv[8 * j + 5] = geluf_(bfhi(w.z)); gv[8 * j + 6] = geluf_(bflo(w.w)); gv[8 * j + 7] = geluf_(bfhi(w.w)); }
#pragma unroll
          for (int i = 0; i < 16; ++i) s += gv[i];
          const float mu = wave_sum(s) * (1.0f / 1024.0f); float q = 0.f;
#pragma unroll
          for (int i = 0; i < 16; ++i) { gv[i] -= mu; q += gv[i] * gv[i]; }
          const float rstd = 1.0f / sqrtf(wave_sum(q) * (1.0f / 1024.0f) + 1e-5f);
#pragma unroll
          for (int j = 0; j < 2; ++j) { const int c = 8 * lane + 512 * j; float o[8];
#pragma unroll
              for (int i = 0; i < 8; ++i) o[i] = gv[8 * j + i] * rstd * gm_ln_g_[l * 1024 + c + i] + gm_ln_b_[l * 1024 + c + i];
              u32x4 w; w.x = pk2(o[0], o[1]); w.y = pk2(o[2], o[3]); w.z = pk2(o[4], o[5]); w.w = pk2(o[6], o[7]); *(u32x4*)(pr + C_V + c) = w;
              if (m >= MP) { float* go = out_ + O_GMV + ((size_t)l * MS + (m - MP)) * 1024 + c; *(f32x4*)go = (f32x4){o[0], o[1], o[2], o[3]}; *(f32x4*)(go + 4) = (f32x4){o[4], o[5], o[6], o[7]}; } } }
        { const int pi = m < MP ? (m & 2047) : SEQ + ((m - MP) & 7); const f32x2 cs = rt[pi * 32 + (lane & 31)];
          for (int hh = 0; hh < 24; ++hh) { const int head = 2 * hh + (lane >> 5);
              bf16* hp = pr + C_Q + head * 64 + (lane & 31); const float x1 = bf2f(hp[0]), x2 = bf2f(hp[32]);
              const float o1 = x1 * cs.x - x2 * cs.y, o2 = x2 * cs.x + x1 * cs.y; hp[0] = (bf16)f2bf(o1); hp[32] = (bf16)f2bf(o2);
              if (head >= 24) { const int gh = head - 24, g = gh >> 3, h = gh & 7; float* ko = kv_out_ptr(out_, l, m, g, 0); if (ko) { ko[h * 64 + (lane & 31)] = o1; ko[h * 64 + 32 + (lane & 31)] = o2; } } } }
#pragma unroll
        for (int g = 0; g < 3; ++g) { float* vo = kv_out_ptr(out_, l, m, g, 1); if (vo) { const u32x4 w = *(const u32x4*)(pr + C_VAL + g * 512 + 8 * lane);
              *(f32x4*)(vo + 8 * lane) = (f32x4){bflo(w.x), bfhi(w.x), bflo(w.y), bfhi(w.y)}; *(f32x4*)(vo + 8 * lane + 4) = (f32x4){bflo(w.z), bfhi(w.z), bflo(w.w), bfhi(w.w)}; } }
    }
}

__device__ __forceinline__ void spatial_phase(const PT& a, int l, LAS unsigned char* lds, int tid, int bid, int G) {
    const float* gm_ws_ = a.gm_ws(); const float* gm_bs_ = a.gm_bs(); unsigned char* ws_ = a.ws();
    const bf16* P = (const bf16*)(ws_ + WS_PROJ); bf16* YA = (bf16*)(ws_ + WS_YA);
    LAS float* wmL = (LAS float*)lds; LAS float* vnL = (LAS float*)(lds + 65536);
    for (int it = bid; it < (256 + DBATCH) * 8; it += G) {
        const int g = it & 7, ci = it >> 3; const int m0 = ci < 256 ? ci * 128 : MP + (ci - 256) * 8, nrows = ci < 256 ? 128 : 8;
        const float* wm = gm_ws_ + ((size_t)l * 8 + g) * 16384;
        for (int e = tid; e < nrows * 128; e += NTHREADS) { wmL[e] = wm[e]; const int s = e >> 7, d = e & 127; vnL[e] = bf2f(P[(size_t)(m0 + s) * NPROJ + C_V + g * 128 + d]); }
        __syncthreads();
        const int d = tid & 127;
        for (int t = tid >> 7; t < nrows; t += 4) { float acc = 0.f;
            for (int s = 0; s <= t; ++s) acc += wmL[t * 128 + s] * vnL[s * 128 + d];
            const float y = acc + gm_bs_[((size_t)l * 8 + g) * 128 + t]; const size_t m = (size_t)(m0 + t); const int col = g * 128 + d;
            const float u = bf2f(P[m * NPROJ + C_U + col]), za = bf2f(P[m * NPROJ + C_ZA + col]);
            YA[m * 1024 + col] = (bf16)f2bf(geluf_(u) * y * siluf_(za)); }
        __syncthreads();
    }
}

__device__ __forceinline__ void attn_prompt_valu(const PT& a, int tid, int bid, int G) {
    unsigned char* ws_ = a.ws();
    const bf16* P = (const bf16*)(ws_ + WS_PROJ); bf16* OG = (bf16*)(ws_ + WS_OG); float* LSE = (float*)(ws_ + WS_LSE);
    for (int it = bid * NTHREADS + tid; it < NBATCH * 3 * 8 * SEQ; it += G * NTHREADS) {
        const int t = it & 2047; int r = it >> 11; const int h = r & 7; r >>= 3; const int g = r % 3, b = r / 3; const int dil = g == 0 ? 1 : g == 1 ? 4 : 16;
        const size_t m = (size_t)b * SEQ + t; const bf16* qp = P + m * NPROJ + C_Q + g * 512 + h * 64;
        float q[64];
#pragma unroll
        for (int c = 0; c < 8; ++c) { const u32x4 w = *(const u32x4*)(qp + 8 * c); q[8 * c + 0] = bflo(w.x) * 0.125f; q[8 * c + 1] = bfhi(w.x) * 0.125f; q[8 * c + 2] = bflo(w.y) * 0.125f; q[8 * c + 3] = bfhi(w.y) * 0.125f;
            q[8 * c + 4] = bflo(w.z) * 0.125f; q[8 * c + 5] = bfhi(w.z) * 0.125f; q[8 * c + 6] = bflo(w.w) * 0.125f; q[8 * c + 7] = bfhi(w.w) * 0.125f; }
        float o[64];
#pragma unroll
        for (int i = 0; i < 64; ++i) o[i] = 0.f;
        float mx = -1e30f, lsum = 0.f;
        for (int j = 0; j <= 128; ++j) { const int tk = t - j * dil; if (tk < 0) break;
            const bf16* kp = P + ((size_t)b * SEQ + tk) * NPROJ + C_K + g * 512 + h * 64; const bf16* vp = kp + (C_VAL - C_K);
            float s = 0.f;
#pragma unroll
            for (int c = 0; c < 8; ++c) { const u32x4 w = *(const u32x4*)(kp + 8 * c);
                s += q[8 * c + 0] * bflo(w.x) + q[8 * c + 1] * bfhi(w.x) + q[8 * c + 2] * bflo(w.y) + q[8 * c + 3] * bfhi(w.y) + q[8 * c + 4] * bflo(w.z) + q[8 * c + 5] * bfhi(w.z) + q[8 * c + 6] * bflo(w.w) + q[8 * c + 7] * bfhi(w.w); }
            const float mn = fmaxf(mx, s), corr = __expf(mx - mn), p = __expf(s - mn); mx = mn; lsum = lsum * corr + p;
#pragma unroll
            for (int c = 0; c < 8; ++c) { const u32x4 w = *(const u32x4*)(vp + 8 * c);
                o[8 * c + 0] = o[8 * c + 0] * corr + p * bflo(w.x); o[8 * c + 1] = o[8 * c + 1] * corr + p * bfhi(w.x); o[8 * c + 2] = o[8 * c + 2] * corr + p * bflo(w.y); o[8 * c + 3] = o[8 * c + 3] * corr + p * bfhi(w.y);
                o[8 * c + 4] = o[8 * c + 4] * corr + p * bflo(w.z); o[8 * c + 5] = o[8 * c + 5] * corr + p * bfhi(w.z); o[8 * c + 6] = o[8 * c + 6] * corr + p * bflo(w.w); o[8 * c + 7] = o[8 * c + 7] * corr + p * bfhi(w.w); }
        }
        const float inv = 1.0f / lsum; bf16* op = OG + (size_t)g * OG_STRIDE + m * 512 + h * 64;
#pragma unroll
        for (int c = 0; c < 8; ++c) { u32x4 w; w.x = pk2(o[8 * c + 0] * inv, o[8 * c + 1] * inv); w.y = pk2(o[8 * c + 2] * inv, o[8 * c + 3] * inv); w.z = pk2(o[8 * c + 4] * inv, o[8 * c + 5] * inv); w.w = pk2(o[8 * c + 6] * inv, o[8 * c + 7] * inv); *(u32x4*)(op + 8 * c) = w; }
        LSE[(size_t)g * LSE_STRIDE + m * 8 + h] = mx + __logf(lsum);
    }
}

__device__ __forceinline__ void attn_sample_phase(const PT& a, int l, int tid, int bid, int G) {
    const float* cache0_ = a.cache0(); const float* cache1_ = a.cache1(); const float* cache2_ = a.cache2(); unsigned char* ws_ = a.ws();
    const int wave = tid >> 6, lane = tid & 63; const int gw = bid * 8 + wave, NGW = G * 8;
    const bf16* P = (const bf16*)(ws_ + WS_PROJ); bf16* OG = (bf16*)(ws_ + WS_OG); float* LSE = (float*)(ws_ + WS_LSE);
    const int h = lane >> 3, ds = (lane & 7) * 8;
    for (int it = gw; it < DBATCH * TDEC * 3; it += NGW) {
        const int g = it % 3, bt = it / 3, b = bt >> 3, t = bt & 7; const int dil = g == 0 ? 1 : g == 1 ? 4 : 16, nprev = 128 * dil;
        const float* cache = (g == 0 ? cache0_ : g == 1 ? cache1_ : cache2_) + ((size_t)l * DBATCH + b) * nprev * 1024;
        const size_t m = (size_t)MP + bt;
        float q[8]; { const u32x4 w = *(const u32x4*)(P + m * NPROJ + C_Q + g * 512 + h * 64 + ds);
            q[0] = bflo(w.x) * 0.125f; q[1] = bfhi(w.x) * 0.125f; q[2] = bflo(w.y) * 0.125f; q[3] = bfhi(w.y) * 0.125f; q[4] = bflo(w.z) * 0.125f; q[5] = bfhi(w.z) * 0.125f; q[6] = bflo(w.w) * 0.125f; q[7] = bfhi(w.w) * 0.125f; }
        float o[8];
#pragma unroll
        for (int i = 0; i < 8; ++i) o[i] = 0.f;
        float mx = -1e30f, lsum = 0.f;
        for (int j = 0; j <= 128; ++j) {
            const int idx = nprev + t - dil * j; float kf[8], vf[8];
            if (idx >= nprev) { const bf16* kp = P + ((size_t)MP + b * 8 + (idx - nprev)) * NPROJ + C_K + g * 512 + h * 64 + ds; const u32x4 kw = *(const u32x4*)kp, vw = *(const u32x4*)(kp + (C_VAL - C_K));
                kf[0] = bflo(kw.x); kf[1] = bfhi(kw.x); kf[2] = bflo(kw.y); kf[3] = bfhi(kw.y); kf[4] = bflo(kw.z); kf[5] = bfhi(kw.z); kf[6] = bflo(kw.w); kf[7] = bfhi(kw.w);
                vf[0] = bflo(vw.x); vf[1] = bfhi(vw.x); vf[2] = bflo(vw.y); vf[3] = bfhi(vw.y); vf[4] = bflo(vw.z); vf[5] = bfhi(vw.z); vf[6] = bflo(vw.w); vf[7] = bfhi(vw.w);
            } else { const float* kp = cache + (size_t)idx * 1024 + h * 64 + ds; const f32x4 k0 = *(const f32x4*)kp, k1 = *(const f32x4*)(kp + 4), v0 = *(const f32x4*)(kp + 512), v1 = *(const f32x4*)(kp + 516);
                kf[0] = k0[0]; kf[1] = k0[1]; kf[2] = k0[2]; kf[3] = k0[3]; kf[4] = k1[0]; kf[5] = k1[1]; kf[6] = k1[2]; kf[7] = k1[3];
                vf[0] = v0[0]; vf[1] = v0[1]; vf[2] = v0[2]; vf[3] = v0[3]; vf[4] = v1[0]; vf[5] = v1[1]; vf[6] = v1[2]; vf[7] = v1[3]; }
            float s = 0.f;
#pragma unroll
            for (int i = 0; i < 8; ++i) s += q[i] * kf[i];
            s += __shfl_xor(s, 1); s += __shfl_xor(s, 2); s += __shfl_xor(s, 4);
            const float mn = fmaxf(mx, s), corr = __expf(mx - mn), p = __expf(s - mn); mx = mn; lsum = lsum * corr + p;
#pragma unroll
            for (int i = 0; i < 8; ++i) o[i] = o[i] * corr + p * vf[i];
        }
        const float inv = 1.0f / lsum; u32x4 w; w.x = pk2(o[0] * inv, o[1] * inv); w.y = pk2(o[2] * inv, o[3] * inv); w.z = pk2(o[4] * inv, o[5] * inv); w.w = pk2(o[6] * inv, o[7] * inv);
        *(u32x4*)(OG + (size_t)g * OG_STRIDE + m * 512 + h * 64 + ds) = w;
        if ((lane & 7) == 0) LSE[(size_t)g * LSE_STRIDE + m * 8 + h] = mx + __logf(lsum);
    }
}

__device__ __forceinline__ void combine_phase(const PT& a, int tid, int bid, int G) {
    unsigned char* ws_ = a.ws();
    const bf16* P = (const bf16*)(ws_ + WS_PROJ); const bf16* OG = (const bf16*)(ws_ + WS_OG); const float* LSE = (const float*)(ws_ + WS_LSE); bf16* YB = (bf16*)(ws_ + WS_YB);
    for (size_t it = (size_t)bid * NTHREADS + tid; it < (size_t)MROWS * 64; it += (size_t)G * NTHREADS) {
        const size_t m = it >> 6; const int c8 = (int)(it & 63), h = c8 >> 3;
        const float l0 = LSE[m * 8 + h], l1 = LSE[LSE_STRIDE + m * 8 + h], l2 = LSE[2 * LSE_STRIDE + m * 8 + h];
        const float mx = fmaxf(l0, fmaxf(l1, l2)); float w0 = __expf(l0 - mx), w1 = __expf(l1 - mx), w2 = __expf(l2 - mx); const float inv = 1.0f / (w0 + w1 + w2); w0 *= inv; w1 *= inv; w2 *= inv;
        const u32x4 a0 = *(const u32x4*)(OG + m * 512 + c8 * 8), a1 = *(const u32x4*)(OG + OG_STRIDE + m * 512 + c8 * 8), a2 = *(const u32x4*)(OG + 2 * OG_STRIDE + m * 512 + c8 * 8);
        const u32x4 zb = *(const u32x4*)(P + m * NPROJ + C_ZB + c8 * 8);
        u32x4 o;
        o.x = pk2((w0 * bflo(a0.x) + w1 * bflo(a1.x) + w2 * bflo(a2.x)) * siluf_(bflo(zb.x)), (w0 * bfhi(a0.x) + w1 * bfhi(a1.x) + w2 * bfhi(a2.x)) * siluf_(bfhi(zb.x)));
        o.y = pk2((w0 * bflo(a0.y) + w1 * bflo(a1.y) + w2 * bflo(a2.y)) * siluf_(bflo(zb.y)), (w0 * bfhi(a0.y) + w1 * bfhi(a1.y) + w2 * bfhi(a2.y)) * siluf_(bfhi(zb.y)));
        o.z = pk2((w0 * bflo(a0.z) + w1 * bflo(a1.z) + w2 * bflo(a2.z)) * siluf_(bflo(zb.z)), (w0 * bfhi(a0.z) + w1 * bfhi(a1.z) + w2 * bfhi(a2.z)) * siluf_(bfhi(zb.z)));
        o.w = pk2((w0 * bflo(a0.w) + w1 * bflo(a1.w) + w2 * bflo(a2.w)) * siluf_(bflo(zb.w)), (w0 * bfhi(a0.w) + w1 * bfhi(a1.w) + w2 * bfhi(a2.w)) * siluf_(bfhi(zb.w)));
        *(u32x4*)(YB + m * 512 + c8 * 8) = o;
    }
}


__global__ void __launch_bounds__(NTHREADS, 2) hybrid_step_fwd(Args ka) {
    extern __shared__ __attribute__((aligned(16))) unsigned char lds_raw[];
    LAS unsigned char* lds = (LAS unsigned char*)lds_raw;
    cg::grid_group grid = cg::this_grid();
    const int bid = blockIdx.x, G = gridDim.x;
    { LAS unsigned long long* pt = (LAS unsigned long long*)(lds + PTAB_OFF);
      if (threadIdx.x == 0) { pt[0] = (unsigned long long)ka.x_prompt; pt[1] = (unsigned long long)ka.x_sample; pt[2] = (unsigned long long)ka.cache0; pt[3] = (unsigned long long)ka.cache1; pt[4] = (unsigned long long)ka.cache2;
          pt[5] = (unsigned long long)ka.c_prompt; pt[6] = (unsigned long long)ka.c_sample; pt[7] = (unsigned long long)ka.w_ada; pt[8] = (unsigned long long)ka.b_ada; pt[9] = (unsigned long long)ka.norm_g;
          pt[10] = (unsigned long long)ka.w_in; pt[11] = (unsigned long long)ka.gm_ln_g; pt[12] = (unsigned long long)ka.gm_ln_b; pt[13] = (unsigned long long)ka.gm_ws; pt[14] = (unsigned long long)ka.gm_bs;
          pt[15] = (unsigned long long)ka.w_gm_out; pt[16] = (unsigned long long)ka.w_att_out; pt[17] = (unsigned long long)ka.w_o; pt[18] = (unsigned long long)ka.final_g; pt[19] = (unsigned long long)ka.out; pt[20] = (unsigned long long)ka.ws; }
      __syncthreads(); }
    PT a; a.t = (LAS const unsigned long long*)(lds + PTAB_OFF);
#define TID() ({ int t_ = threadIdx.x; asm volatile("" : "+v"(t_)); t_; })
#define WSP(T, off) ((T*)(a.ws() + (off)))

    p0_phase(a, lds, TID(), bid, G);
    grid.sync();
    norm_phase(a, 0, nullptr, TID(), bid, G);
    grid.sync();
    for (int l = 0; l < 2; ++l) {
        { pg8::Gemm g{WSP(bf16, WS_H), WSP(bf16, WS_WTIN) + (size_t)l * NPROJ * 1024, MROWS, NPROJ, 1024}; pg8::StaticOrder S; S.init(MROWS, NPROJ, G, bid);
          pg8::EpiStoreBf16 E{WSP(bf16, WS_PROJ), NPROJ}; pg8::gemm_phase<pg8::EpiStoreBf16, pg8::StaticOrder, true, true>(lds, g, S, E); }
        grid.sync();
        p2a_phase(a, l, TID(), bid, G);
        grid.sync();
        spatial_phase(a, l, lds, TID(), bid, G);
        attn_sample_phase(a, l, TID(), bid, G);
        attn_prompt_valu(a, TID(), bid, G);
        grid.sync();
        combine_phase(a, TID(), bid, G);
        grid.sync();
        { pg8::Gemm g{WSP(bf16, WS_YA), WSP(bf16, WS_WTGM) + (size_t)l * 1024 * 1024, MROWS, 1024, 1024}; pg8::StaticOrder S; S.init(MROWS, 1024, G, bid);
          pg8::EpiGate1 E{WSP(float, WS_T), WSP(bf16, WS_PROJ) + C_GA, NPROJ}; pg8::gemm_phase<pg8::EpiGate1, pg8::StaticOrder, true, true>(lds, g, S, E); }
        { pg8::Gemm g{WSP(bf16, WS_YB), WSP(bf16, WS_WTATT) + (size_t)l * 1024 * 512, MROWS, 1024, 512}; pg8::StaticOrder S; S.init(MROWS, 1024, G, bid);
          pg8::EpiGate2 E{WSP(float, WS_T), WSP(bf16, WS_PROJ) + C_GB, NPROJ, WSP(bf16, WS_MERGED)}; pg8::gemm_phase<pg8::EpiGate2, pg8::StaticOrder, true, true>(lds, g, S, E); }
        grid.sync();
        { pg8::Gemm g{WSP(bf16, WS_MERGED), WSP(bf16, WS_WTO) + (size_t)l * 1024 * 1024, MROWS, 1024, 1024}; pg8::StaticOrder S; S.init(MROWS, 1024, G, bid);
          float* XB = WSP(float, WS_X);
          pg8::EpiResid E{l == 0 ? a.x_prompt() : XB, l == 0 ? a.x_sample() : XB + (size_t)MP * 1024, WSP(float, WS_MOD) + (size_t)l * NCOND * 3072 + 2048, XB};
          pg8::gemm_phase<pg8::EpiResid, pg8::StaticOrder, true, true>(lds, g, S, E); }
        grid.sync();
        norm_phase(a, l + 1, WSP(float, WS_X), TID(), bid, G);
        if (l == 0) grid.sync();
    }
}

extern "C" void kernel_launch(void* const* d_in, const int* in_sizes, int n_in, void* d_out, int out_size, void* d_ws, size_t ws_size, hipStream_t stream) {
    static int grid = 0;
    if (grid == 0) {
        if (n_in != 19 || (size_t)out_size != O_TOTAL || ws_size < WS_END) { fprintf(stderr, "kernel_launch: unexpected sizes: n_in %d out %d (want %zu) ws %zu (want >= %zu)\n", n_in, out_size, (size_t)O_TOTAL, ws_size, (size_t)WS_END); grid = -1; return; }
        int dev = 0, cus = 0, per_cu = 0;
        hipGetDevice(&dev); hipDeviceGetAttribute(&cus, hipDeviceAttributeMultiprocessorCount, dev);
        if (hipFuncSetAttribute((const void*)hybrid_step_fwd, hipFuncAttributeMaxDynamicSharedMemorySize, LDS_BYTES) != hipSuccess) { fprintf(stderr, "kernel_launch: hipFuncSetAttribute failed\n"); grid = -1; return; }
        if (hipOccupancyMaxActiveBlocksPerMultiprocessor(&per_cu, (const void*)hybrid_step_fwd, NTHREADS, LDS_BYTES) != hipSuccess || per_cu < 1) { fprintf(stderr, "kernel_launch: occupancy query failed (%d)\n", per_cu); (void)hipGetLastError(); grid = -1; return; }
        grid = cus * per_cu;
        fprintf(stderr, "kernel_launch: %d CUs x %d blocks/CU -> grid %d\n", cus, per_cu, grid);
    }
    if (grid < 0) return;
    Args a{};
    a.x_prompt = (const float*)d_in[0]; a.x_sample = (const float*)d_in[1]; a.cache0 = (const float*)d_in[2]; a.cache1 = (const float*)d_in[3]; a.cache2 = (const float*)d_in[4];
    a.c_prompt = (const float*)d_in[5]; a.c_sample = (const float*)d_in[6]; a.w_ada = (const float*)d_in[7]; a.b_ada = (const float*)d_in[8]; a.norm_g = (const float*)d_in[9];
    a.w_in = (const float*)d_in[10]; a.gm_ln_g = (const float*)d_in[11]; a.gm_ln_b = (const float*)d_in[12]; a.gm_ws = (const float*)d_in[13]; a.gm_bs = (const float*)d_in[14];
    a.w_gm_out = (const float*)d_in[15]; a.w_att_out = (const float*)d_in[16]; a.w_o = (const float*)d_in[17]; a.final_g = (const float*)d_in[18];
    a.out = (float*)d_out; a.ws = (unsigned char*)d_ws;
    void* args[] = {&a};
    hipError_t e = hipLaunchCooperativeKernel((const void*)hybrid_step_fwd, dim3(grid), dim3(NTHREADS), args, LDS_BYTES, stream);
    if (e != hipSuccess) fprintf(stderr, "kernel_launch: cooperative launch failed: %s (grid %d)\n", hipGetErrorString(e), grid);
}
```

```cpp
#include <hip/hip_runtime.h>
#include <hip/hip_cooperative_groups.h>
#include <cstdio>
#include <cstdint>
#include <cmath>
namespace cg = cooperative_groups;

constexpr int D = 1024, SEQ = 2048, NBATCH = 16, MP = NBATCH * SEQ, DBATCH = 32, TDEC = 8, MS = DBATCH * TDEC, MROWS = MP + MS;
constexpr int NPROJ = 10240, NCOND = 48, PAST = 16384;
constexpr int C_U = 0, C_V = 1024, C_ZA = 2048, C_Q = 3072, C_K = 4608, C_VAL = 6144, C_ZB = 7680, C_GA = 8192, C_GB = 9216;
constexpr size_t O_Y = 0, O_KVP0 = (size_t)MROWS * 1024, O_KVP1 = O_KVP0 + 4194304, O_KVP2 = O_KVP1 + 16777216, O_KVS0 = O_KVP2 + 67108864,
                 O_KVS1 = O_KVS0 + 524288, O_KVS2 = O_KVS1 + 524288, O_GMV = O_KVS2 + 524288, O_TOTAL = O_GMV + 524288;

typedef unsigned short bf16;
typedef float f32x4 __attribute__((ext_vector_type(4)));
typedef float f32x2 __attribute__((ext_vector_type(2)));
typedef unsigned u32x4 __attribute__((ext_vector_type(4)));
typedef unsigned u32x2 __attribute__((ext_vector_type(2)));
#define LAS __attribute__((address_space(3)))

__device__ __forceinline__ float sigmoidf_(float z) { return __builtin_amdgcn_rcpf(1.0f + __builtin_amdgcn_exp2f(-1.4426950408889634f * z)); }
__device__ __forceinline__ float siluf_(float z) { return z * sigmoidf_(z); }
__device__ __forceinline__ float geluf_(float x) { return x * sigmoidf_(1.5957691216057308f * (x + 0.044715f * x * x * x)); }
__device__ __forceinline__ unsigned f2bf(float f) { unsigned u = __builtin_bit_cast(unsigned, f); return (u + 0x7fffu + ((u >> 16) & 1u)) >> 16; }
__device__ __forceinline__ unsigned pk2(float lo, float hi) { return f2bf(lo) | (f2bf(hi) << 16); }
__device__ __forceinline__ float bflo(unsigned w) { return __builtin_bit_cast(float, w << 16); }
__device__ __forceinline__ float bfhi(unsigned w) { return __builtin_bit_cast(float, w & 0xffff0000u); }
__device__ __forceinline__ float bf2f(bf16 b) { return __builtin_bit_cast(float, (unsigned)b << 16); }
__device__ __forceinline__ int cond_row(int m) { return m < MP ? (m >> 11) : NBATCH + ((m - MP) >> 3); }

namespace pg8 {
#define PG8_LAS __attribute__((address_space(3)))
typedef unsigned short bf16_t;
typedef short bf16x8 __attribute__((ext_vector_type(8)));
typedef float f32x4 __attribute__((ext_vector_type(4)));
typedef unsigned u32x4 __attribute__((ext_vector_type(4)));
constexpr int BM = 256, BK = 64, HALF = 128, HTB = HALF * BK * 2  , STAGE_BYTES = 8 * HTB, NXCD = 8, WGM = 8;

__host__ __device__ __forceinline__ int lds_byte(int r, int c) { const int st = (r >> 4) * 2 + (c >> 5), rr = r & 15, cc = c & 31, ob = rr * 64 + cc * 2; return st * 1024 + (ob ^ (((ob >> 9) & 1) << 5)); }
__host__ __device__ __forceinline__ void stage_rc(int b, int& R, int& C) { const int st = b / 1024, sb = b % 1024, swz = sb ^ (((sb >> 9) & 1) << 5); R = (st >> 1) * 16 + swz / 64; C = (st & 1) * 32 + (swz % 64) / 2; }
__host__ __device__ __forceinline__ int perm32(int rho) { const int n = rho >> 4, i = rho & 15; return 8 * (i >> 2) + 4 * n + (i & 3); }

struct Unit { int pm, pn; };
struct Gemm { const bf16_t* A; const bf16_t* Bt; int M, N, K; };

struct StaticOrder {
    int nM, nN, nwg, G, c;
    __host__ __device__ void init(int M, int N, int G_, int c_) { nM = M / BM; nN = N / BM; nwg = nM * nN; G = G_; c = c_; }
    __host__ __device__ bool next(int i, Unit& u) const {
        const long L = (long)i * G + c; if (L >= nwg) return false;
        int wgid = (int)L; { const int q = nwg / NXCD, r = nwg % NXCD, xcd = wgid % NXCD, off = wgid / NXCD; wgid = (xcd < r ? xcd * (q + 1) : r * (q + 1) + (xcd - r) * q) + off; }
        const int nig = WGM * nN, gid = wgid / nig, fm = gid * WGM, gsz = (nM - fm) < WGM ? (nM - fm) : WGM;
        u.pm = fm + ((wgid % nig) % gsz); u.pn = (wgid % nig) / gsz; return true;
    }
    __device__ __forceinline__ void a_ready(const Unit&) const {}
    __device__ __forceinline__ void done(const Unit&) const {}
};

__device__ __forceinline__ unsigned cvt_pk_bf16(float lo, float hi) { unsigned r; asm volatile("v_cvt_pk_bf16_f32 %0, %1, %2" : "=v"(r) : "v"(lo), "v"(hi)); return r; }
typedef float f32x2 __attribute__((ext_vector_type(2)));
struct EpiStoreBf16 {
    static constexpr bool PERM = true, AFTER_DRAIN = false;
    bf16_t* O; int ldc;
    __device__ __forceinline__ void operator()(const f32x4 (&acc)[2][2][4][2], const Unit& u, int wr, int wc, int fr, int fq) const {
        const int row0 = u.pm * BM + wr * 64 + fr, col0 = u.pn * BM + wc * 32 + 8 * fq;
#pragma unroll
        for (int ai = 0; ai < 2; ++ai)
#pragma unroll
            for (int m = 0; m < 4; ++m) { bf16_t* rowp = O + (size_t)(row0 + ai * HALF + m * 16) * ldc + col0;
#pragma unroll
                for (int bj = 0; bj < 2; ++bj) { const f32x4 v0 = acc[ai][bj][m][0], v1 = acc[ai][bj][m][1];
                    u32x4 w; w.x = cvt_pk_bf16(v0[0], v0[1]); w.y = cvt_pk_bf16(v0[2], v0[3]); w.z = cvt_pk_bf16(v1[0], v1[1]); w.w = cvt_pk_bf16(v1[2], v1[3]);
                    *(u32x4*)(rowp + bj * HALF) = w; } }
    }
};
struct EpiGate1 {
    static constexpr bool PERM = false, AFTER_DRAIN = false;
    float* Tq; const bf16_t* G; int ldg;
    __device__ __forceinline__ void operator()(const f32x4 (&acc)[2][2][4][2], const Unit& u, int wr, int wc, int fr, int fq) const {
        const int row0 = u.pm * BM + wr * 64 + fr, col0 = u.pn * BM + wc * 32 + 4 * fq;
#pragma unroll
        for (int ai = 0; ai < 2; ++ai)
#pragma unroll
            for (int m = 0; m < 4; ++m) { const size_t r = (size_t)(row0 + ai * HALF + m * 16);
#pragma unroll
                for (int bj = 0; bj < 2; ++bj)
#pragma unroll
                    for (int n = 0; n < 2; ++n) { const int c = col0 + bj * HALF + n * 16; const u32x2 gw = *(const u32x2*)(G + r * ldg + c);
                        f32x4 o; o[0] = ::sigmoidf_(::bflo(gw.x)) * acc[ai][bj][m][n][0]; o[1] = ::sigmoidf_(::bfhi(gw.x)) * acc[ai][bj][m][n][1];
                        o[2] = ::sigmoidf_(::bflo(gw.y)) * acc[ai][bj][m][n][2]; o[3] = ::sigmoidf_(::bfhi(gw.y)) * acc[ai][bj][m][n][3];
                        *(f32x4*)(Tq + r * 1024 + c) = o; } }
    }
};
struct EpiGate2 {
    static constexpr bool PERM = false, AFTER_DRAIN = false;
    const float* Tq; const bf16_t* G; int ldg; bf16_t* O;
    __device__ __forceinline__ void operator()(const f32x4 (&acc)[2][2][4][2], const Unit& u, int wr, int wc, int fr, int fq) const {
        const int row0 = u.pm * BM + wr * 64 + fr, col0 = u.pn * BM + wc * 32 + 4 * fq;
#pragma unroll
        for (int ai = 0; ai < 2; ++ai)
#pragma unroll
            for (int m = 0; m < 4; ++m) { const size_t r = (size_t)(row0 + ai * HALF + m * 16);
#pragma unroll
                for (int bj = 0; bj < 2; ++bj)
#pragma unroll
                    for (int n = 0; n < 2; ++n) { const int c = col0 + bj * HALF + n * 16; const u32x2 gw = *(const u32x2*)(G + r * ldg + c); const f32x4 t = *(const f32x4*)(Tq + r * 1024 + c);
                        const float o0 = t[0] + ::sigmoidf_(::bflo(gw.x)) * acc[ai][bj][m][n][0], o1 = t[1] + ::sigmoidf_(::bfhi(gw.x)) * acc[ai][bj][m][n][1];
                        const float o2 = t[2] + ::sigmoidf_(::bflo(gw.y)) * acc[ai][bj][m][n][2], o3 = t[3] + ::sigmoidf_(::bfhi(gw.y)) * acc[ai][bj][m][n][3];
                        u32x2 w; w.x = cvt_pk_bf16(o0, o1); w.y = cvt_pk_bf16(o2, o3); *(u32x2*)(O + r * 1024 + c) = w; } }
    }
};
struct EpiResid {
    static constexpr bool PERM = false, AFTER_DRAIN = false;
    const float* xp; const float* xs; const float* gate  ; float* xo;
    __device__ __forceinline__ void operator()(const f32x4 (&acc)[2][2][4][2], const Unit& u, int wr, int wc, int fr, int fq) const {
        const int row0 = u.pm * BM + wr * 64 + fr, col0 = u.pn * BM + wc * 32 + 4 * fq;
#pragma unroll
        for (int ai = 0; ai < 2; ++ai)
#pragma unroll
            for (int m = 0; m < 4; ++m) { const int r = row0 + ai * HALF + m * 16; const float* xr = r < ::MP ? xp + (size_t)r * 1024 : xs + (size_t)(r - ::MP) * 1024;
                const float* gr = gate + (size_t)::cond_row(r) * 3072;
#pragma unroll
                for (int bj = 0; bj < 2; ++bj)
#pragma unroll
                    for (int n = 0; n < 2; ++n) { const int c = col0 + bj * HALF + n * 16; const f32x4 xv = *(const f32x4*)(xr + c), gv = *(const f32x4*)(gr + c);
                        *(f32x4*)(xo + (size_t)r * 1024 + c) = xv + gv * acc[ai][bj][m][n]; } }
    }
};
template <class Epi, class Sched, bool ALIGN_EPI = false, bool SP2 = false>
__device__ __forceinline__ void gemm_phase(PG8_LAS unsigned char* lds, const Gemm g, const Sched& S, const Epi& E) {
    int tid_ = threadIdx.x; asm volatile("" : "+v"(tid_));
    const int tid = tid_, wid = __builtin_amdgcn_readfirstlane(tid >> 6), lane = tid & 63, wr = wid >> 2, wc = wid & 3, fr = lane & 15, fq = lane >> 4;
    const int K = g.K, nt = K / BK;
    unsigned voffA[2], voffB[2];
#pragma unroll
    for (int i = 0; i < 2; ++i) { int R, C; stage_rc(tid * 16 + i * 8192, R, C); const int Rb = Epi::PERM ? ((R & ~31) + perm32(R & 31)) : R;
        voffA[i] = (unsigned)(R * K + C) * 2u; voffB[i] = (unsigned)(Rb * K + C) * 2u; }
    const size_t kstep = (size_t)(BK * 2);
    const size_t hstep = (size_t)HALF * K * 2;
    const size_t tstep = 2 * hstep;
    const unsigned ldsw = (unsigned)wid * 1024u;
    const int aoff = lds_byte(wr * 64 + fr, fq * 8), boff = lds_byte(wc * 32 + fr, fq * 8);
#define PG8_SA(b, h) (((b) * 2 + (h)) * HTB)
#define PG8_SB(b, h) ((4 + (b) * 2 + (h)) * HTB)
#define PG8_STAGE(bufoff, gbase, voff) do { _Pragma("unroll") for (int _i = 0; _i < 2; ++_i) \
        __builtin_amdgcn_global_load_lds((const unsigned*)((const char*)(gbase) + (voff)[_i]), (PG8_LAS unsigned*)(lds + (bufoff) + ldsw + _i * 8192), 16, 0, 0); } while (0)
#define PG8_LDA(dst, b, h) do { _Pragma("unroll") for (int m = 0; m < 4; ++m) _Pragma("unroll") for (int k = 0; k < 2; ++k) dst[m][k] = *(const PG8_LAS bf16x8*)(lds + PG8_SA(b, h) + aoff + m * 2048 + k * 1024); } while (0)
#define PG8_LDB(dst, b, h) do { _Pragma("unroll") for (int n = 0; n < 2; ++n) _Pragma("unroll") for (int k = 0; k < 2; ++k) dst[n][k] = *(const PG8_LAS bf16x8*)(lds + PG8_SB(b, h) + boff + n * 2048 + k * 1024); } while (0)
#define PG8_MMA(ai, bj, At, Bt) do { __builtin_amdgcn_s_setprio(1); _Pragma("unroll") for (int m = 0; m < 4; ++m) _Pragma("unroll") for (int n = 0; n < 2; ++n) _Pragma("unroll") for (int k = 0; k < 2; ++k) \
        acc[ai][bj][m][n] = __builtin_amdgcn_mfma_f32_16x16x32_bf16(Bt[n][k], At[m][k], acc[ai][bj][m][n], 0, 0, 0); __builtin_amdgcn_s_setprio(0); } while (0)
#define PG8_WAIT_V(n) asm volatile("s_waitcnt vmcnt(" #n ")" ::: "memory")
#define PG8_WAIT_L(n) asm volatile("s_waitcnt lgkmcnt(" #n ")" ::: "memory")
#define PG8_BAR __builtin_amdgcn_s_barrier()
#define PG8_SCHED __builtin_amdgcn_sched_barrier(0)
    Unit cur, nxt; int ui = 0;
    if (!S.next(0, cur)) return;
    f32x4 acc[2][2][4][2];
#pragma unroll
    for (int a = 0; a < 2; ++a)
#pragma unroll
        for (int b = 0; b < 2; ++b)
#pragma unroll
            for (int m = 0; m < 4; ++m)
#pragma unroll
                for (int n = 0; n < 2; ++n) acc[a][b][m][n] = (f32x4){0.f, 0.f, 0.f, 0.f};
    bf16x8 At[4][2], B0[2][2], B1[2][2];
    const char* cA = (const char*)g.A + (size_t)cur.pm * tstep; const char* cB = (const char*)g.Bt + (size_t)cur.pn * tstep;
    S.a_ready(cur);
    if constexpr (SP2) {
        PG8_STAGE(PG8_SB(0, 0), cB, voffB); PG8_STAGE(PG8_SB(0, 1), cB + hstep, voffB); PG8_STAGE(PG8_SA(0, 0), cA, voffA); PG8_STAGE(PG8_SA(0, 1), cA + hstep, voffA);
        if (wr == 1) PG8_BAR;
        PG8_WAIT_V(2); PG8_BAR;
        PG8_STAGE(PG8_SB(1, 0), cB + kstep, voffB); PG8_STAGE(PG8_SA(1, 0), cA + kstep, voffA); PG8_STAGE(PG8_SB(1, 1), cB + hstep + kstep, voffB);
        PG8_WAIT_V(6); PG8_BAR;
    } else {
        PG8_STAGE(PG8_SB(0, 0), cB, voffB); PG8_STAGE(PG8_SA(0, 0), cA, voffA); PG8_STAGE(PG8_SB(0, 1), cB + hstep, voffB); PG8_STAGE(PG8_SA(0, 1), cA + hstep, voffA);
        if (wr == 1) PG8_BAR;
        PG8_WAIT_V(4); PG8_BAR;
        PG8_STAGE(PG8_SB(1, 0), cB + kstep, voffB); PG8_STAGE(PG8_SA(1, 0), cA + kstep, voffA); PG8_STAGE(PG8_SB(1, 1), cB + hstep + kstep, voffB);
        PG8_WAIT_V(6); PG8_BAR;
    }
    for (;;) {
        const bool has_next = S.next(ui + 1, nxt);
        const char* nA = has_next ? (const char*)g.A + (size_t)nxt.pm * tstep : cA; const char* nB = has_next ? (const char*)g.Bt + (size_t)nxt.pn * tstep : cB;
        for (int t = 0; t < nt; t += 2) {
            const bool last = (t == nt - 2);
            const char* a1 = cA + (size_t)(t + 1) * kstep;
            const char* a2 = last ? nA : cA + (size_t)(t + 2) * kstep; const char* b2 = last ? nB : cB + (size_t)(t + 2) * kstep;
            const char* a3 = a2 + kstep; const char* b3 = b2 + kstep;
            if (last && has_next) S.a_ready(nxt);
            if constexpr (SP2) {
            PG8_LDB(B0, 0, 0); PG8_LDB(B1, 0, 1); PG8_SCHED; PG8_LDA(At, 0, 0); PG8_STAGE(PG8_SA(1, 1), a1 + hstep, voffA);
            PG8_WAIT_V(8); PG8_WAIT_L(0); PG8_BAR; PG8_MMA(0, 0, At, B0); PG8_MMA(0, 1, At, B1); PG8_BAR; PG8_SCHED;
            PG8_LDA(At, 0, 1); PG8_STAGE(PG8_SB(0, 0), b2, voffB); PG8_STAGE(PG8_SB(0, 1), b2 + hstep, voffB); PG8_STAGE(PG8_SA(0, 0), a2, voffA);
            PG8_WAIT_V(8); PG8_WAIT_L(0); PG8_BAR; PG8_MMA(1, 0, At, B0); PG8_MMA(1, 1, At, B1); PG8_BAR; PG8_SCHED;
            PG8_LDB(B0, 1, 0); PG8_LDB(B1, 1, 1); PG8_SCHED; PG8_LDA(At, 1, 0); PG8_STAGE(PG8_SA(0, 1), a2 + hstep, voffA);
            PG8_WAIT_V(8); PG8_WAIT_L(0); PG8_BAR; PG8_MMA(0, 0, At, B0); PG8_MMA(0, 1, At, B1); PG8_BAR; PG8_SCHED;
            PG8_LDA(At, 1, 1); PG8_STAGE(PG8_SB(1, 0), b3, voffB); PG8_STAGE(PG8_SB(1, 1), b3 + hstep, voffB); PG8_STAGE(PG8_SA(1, 0), a3, voffA);
            PG8_WAIT_V(8); PG8_WAIT_L(0); PG8_BAR; PG8_MMA(1, 0, At, B0); PG8_MMA(1, 1, At, B1); PG8_BAR; PG8_SCHED;
            } else {
            PG8_LDB(B0, 0, 0); PG8_SCHED; PG8_LDA(At, 0, 0); PG8_STAGE(PG8_SA(1, 1), a1 + hstep, voffA);
            PG8_WAIT_L(8); PG8_BAR; PG8_WAIT_L(0); PG8_MMA(0, 0, At, B0); PG8_BAR; PG8_SCHED;
            PG8_LDB(B1, 0, 1); PG8_STAGE(PG8_SB(0, 0), b2, voffB);
            PG8_BAR; PG8_WAIT_L(0); PG8_MMA(0, 1, At, B1); PG8_BAR;
            PG8_LDA(At, 0, 1); PG8_STAGE(PG8_SA(0, 0), a2, voffA);
            PG8_BAR; PG8_WAIT_L(0); PG8_MMA(1, 0, At, B0); PG8_BAR; PG8_SCHED;
            PG8_STAGE(PG8_SB(0, 1), b2 + hstep, voffB);
            PG8_WAIT_V(6); PG8_BAR; PG8_MMA(1, 1, At, B1); PG8_BAR;
            PG8_LDB(B0, 1, 0); PG8_SCHED; PG8_LDA(At, 1, 0); PG8_STAGE(PG8_SA(0, 1), a2 + hstep, voffA);
            PG8_WAIT_L(8); PG8_BAR; PG8_WAIT_L(0); PG8_MMA(0, 0, At, B0); PG8_BAR; PG8_SCHED;
            PG8_LDB(B1, 1, 1); PG8_STAGE(PG8_SB(1, 0), b3, voffB);
            PG8_BAR; PG8_WAIT_L(0); PG8_MMA(0, 1, At, B1); PG8_BAR;
            PG8_LDA(At, 1, 1); PG8_STAGE(PG8_SA(1, 0), a3, voffA);
            PG8_BAR; PG8_WAIT_L(0); PG8_MMA(1, 0, At, B0); PG8_BAR; PG8_SCHED;
            PG8_STAGE(PG8_SB(1, 1), b3 + hstep, voffB);
            PG8_WAIT_V(6); PG8_BAR; PG8_MMA(1, 1, At, B1); PG8_BAR;
            }
        }
        if constexpr (ALIGN_EPI) { if (wr == 0) PG8_BAR; }
        if constexpr (!Epi::AFTER_DRAIN) { E(acc, cur, wr, wc, fr, fq); S.done(cur); }
        if (!has_next) break;
#pragma unroll
        for (int a = 0; a < 2; ++a)
#pragma unroll
            for (int b = 0; b < 2; ++b)
#pragma unroll
                for (int m = 0; m < 4; ++m)
#pragma unroll
                    for (int n = 0; n < 2; ++n) acc[a][b][m][n] = (f32x4){0.f, 0.f, 0.f, 0.f};
        cur = nxt; cA = nA; cB = nB; ++ui;
        if constexpr (ALIGN_EPI) { if (wr == 1) PG8_BAR; }
    }
    PG8_WAIT_V(0);
    if constexpr (!ALIGN_EPI) { if (wr == 0) PG8_BAR; }
    PG8_BAR;
    if constexpr (Epi::AFTER_DRAIN) { E.fused(acc, cur, wr, wc, fr, fq, lds, wid, lane); S.done(cur); }
#undef PG8_SA
#undef PG8_SB
#undef PG8_STAGE
#undef PG8_LDA
#undef PG8_LDB
#undef PG8_MMA
#undef PG8_WAIT_V
#undef PG8_WAIT_L
#undef PG8_BAR
#undef PG8_SCHED
}
}

constexpr size_t MiB = 1u << 20;
constexpr size_t WS_MOD = 1 * MiB, WS_ROPE = 3 * MiB, WS_WTIN = 4 * MiB, WS_WTGM = 44 * MiB, WS_WTATT = 48 * MiB, WS_WTO = 50 * MiB,
                 WS_H = 56 * MiB, WS_YA = 122 * MiB, WS_YB = 188 * MiB, WS_OG = 222 * MiB, WS_LSE = 320 * MiB, WS_MERGED = 324 * MiB,
                 WS_T = 390 * MiB, WS_X = 520 * MiB, WS_PROJ = 650 * MiB, WS_END = 1296 * MiB;
constexpr size_t OG_STRIDE = (size_t)MROWS * 512;
constexpr size_t LSE_STRIDE = (size_t)MROWS * 8;
constexpr int LDS_BYTES = 147456;
constexpr int NTHREADS = 512;

struct Args {
    const float* x_prompt; const float* x_sample; const float* cache0; const float* cache1; const float* cache2; const float* c_prompt; const float* c_sample;
    const float* w_ada; const float* b_ada; const float* norm_g; const float* w_in; const float* gm_ln_g; const float* gm_ln_b; const float* gm_ws; const float* gm_bs;
    const float* w_gm_out; const float* w_att_out; const float* w_o; const float* final_g;
    float* out; unsigned char* ws;
};
constexpr int PTAB_OFF = 131072 + 1024;
struct PT {
    LAS const unsigned long long* t;
    __device__ __forceinline__ unsigned long long g(int i) const { const unsigned long long v = t[i]; const unsigned lo = __builtin_amdgcn_readfirstlane((unsigned)v), hi = __builtin_amdgcn_readfirstlane((unsigned)(v >> 32)); return ((unsigned long long)hi << 32) | lo; }
#define GASP(v) ((__attribute__((address_space(1))) unsigned char*)(v))
#define PTF(name, idx) __device__ __forceinline__ const float* name() const { return (const float*)GASP(g(idx)); }
    PTF(x_prompt, 0) PTF(x_sample, 1) PTF(cache0, 2) PTF(cache1, 3) PTF(cache2, 4) PTF(c_prompt, 5) PTF(c_sample, 6) PTF(w_ada, 7) PTF(b_ada, 8) PTF(norm_g, 9) PTF(w_in, 10)
    PTF(gm_ln_g, 11) PTF(gm_ln_b, 12) PTF(gm_ws, 13) PTF(gm_bs, 14) PTF(w_gm_out, 15) PTF(w_att_out, 16) PTF(w_o, 17) PTF(final_g, 18)
#undef PTF
    __device__ __forceinline__ float* out() const { return (float*)GASP(g(19)); }
    __device__ __forceinline__ unsigned char* ws() const { return (unsigned char*)GASP(g(20)); }
};
__device__ const float INV_FREQ[32] = {1.000000000e+00f, 7.498942614e-01f, 5.623413324e-01f, 4.216965139e-01f, 3.162277639e-01f, 2.371373773e-01f, 1.778279394e-01f, 1.333521307e-01f, 1.000000015e-01f, 7.498941571e-02f, 5.623413250e-02f, 4.216965288e-02f, 3.162277490e-02f, 2.371373773e-02f, 1.778279431e-02f, 1.333521493e-02f, 9.999999776e-03f, 7.498941850e-03f, 5.623413250e-03f, 4.216964822e-03f, 3.162277630e-03f, 2.371373586e-03f, 1.778279431e-03f, 1.333521446e-03f, 1.000000047e-03f, 7.498942432e-04f, 5.623413017e-04f, 4.216965172e-04f, 3.162277571e-04f, 2.371373703e-04f, 1.778279402e-04f, 1.333521504e-04f};

__device__ __forceinline__ float wave_sum(float v) {
#pragma unroll
    for (int o = 1; o < 64; o <<= 1) v += __shfl_xor(v, o);
    return v;
}

__device__ __forceinline__ void p0_transpose_item(const float* W, int K, int N, bf16* WT, LAS float* scr, int item, int lane) {
    const int nblk = N / 32, kb = item / nblk, nb = item % nblk, k0 = 64 * kb, n0 = 32 * nb;
#pragma unroll 8
    for (int i = 0; i < 32; ++i) { const int kk = 2 * i + (lane >> 5); scr[kk * 33 + (lane & 31)] = W[(size_t)(k0 + kk) * N + n0 + (lane & 31)]; }
    asm volatile("s_waitcnt lgkmcnt(0)" ::: "memory");
    const int c = lane & 7;
#pragma unroll
    for (int j = 0; j < 4; ++j) { const int n = (lane >> 3) + 8 * j; const LAS float* s = scr + (8 * c) * 33 + n;
        u32x4 o; o.x = pk2(s[0 * 33], s[1 * 33]); o.y = pk2(s[2 * 33], s[3 * 33]); o.z = pk2(s[4 * 33], s[5 * 33]); o.w = pk2(s[6 * 33], s[7 * 33]);
        *(u32x4*)(WT + (size_t)(n0 + n) * K + k0 + 8 * c) = o; }
    asm volatile("s_waitcnt lgkmcnt(0)" ::: "memory");
}

__device__ __forceinline__ void p0_mod_item(const PT& a, LAS unsigned char* lds, int item, int tid) {
    const float* c_prompt_ = a.c_prompt(); const float* c_sample_ = a.c_sample(); const float* w_ada_ = a.w_ada(); const float* b_ada_ = a.b_ada(); unsigned char* ws_ = a.ws();
    const int wave = tid >> 6, lane = tid & 63;
    const int rg = item % 3; const int r2 = item / 3; const int cb = r2 % 48; const int l = r2 / 48;
    const int row0 = rg * 16, col = cb * 64 + lane, k0 = wave * 128;
    LAS float* tab = (LAS float*)(lds + wave * 8192);
    for (int e = lane; e < 2048; e += 64) { const int rr = e >> 7, kk = e & 127; const int cr = row0 + rr;
        const float* cp = cr < NBATCH ? c_prompt_ + (size_t)cr * 1024 : c_sample_ + (size_t)(cr - NBATCH) * 1024; tab[e] = siluf_(cp[k0 + kk]); }
    asm volatile("s_waitcnt lgkmcnt(0)" ::: "memory");
    float acc[16];
#pragma unroll
    for (int r = 0; r < 16; ++r) acc[r] = 0.f;
    const float* wp = w_ada_ + (size_t)l * 1024 * 3072 + (size_t)k0 * 3072 + col;
#pragma unroll 2
    for (int kk = 0; kk < 128; kk += 4) {
        const float w0 = wp[(size_t)(kk + 0) * 3072], w1 = wp[(size_t)(kk + 1) * 3072], w2 = wp[(size_t)(kk + 2) * 3072], w3 = wp[(size_t)(kk + 3) * 3072];
#pragma unroll
        for (int r = 0; r < 16; ++r) { const f32x4 t = *(const LAS f32x4*)(tab + r * 128 + kk); acc[r] += (t[0] * w0 + t[1] * w1) + (t[2] * w2 + t[3] * w3); }
    }
    LAS float* red = (LAS float*)(lds + 65536);
#pragma unroll
    for (int r = 0; r < 16; ++r) red[(wave * 16 + r) * 64 + lane] = acc[r];
    __syncthreads();
    float* mod = (float*)(ws_ + WS_MOD);
    for (int e = tid; e < 1024; e += NTHREADS) { const int rr = e >> 6, cc = e & 63; float s = 0.f;
#pragma unroll
        for (int w = 0; w < 8; ++w) s += red[(w * 16 + rr) * 64 + cc];
        const int colg = cb * 64 + cc; mod[((size_t)l * NCOND + row0 + rr) * 3072 + colg] = s + b_ada_[l * 3072 + colg]; }
    __syncthreads();
}

__device__ __forceinline__ void p0_phase(const PT& a, LAS unsigned char* lds, int tid, int bid, int G) {
    const float* w_in_ = a.w_in(); const float* w_gm_out_ = a.w_gm_out(); const float* w_att_out_ = a.w_att_out(); const float* w_o_ = a.w_o(); unsigned char* ws_ = a.ws();
    const int wave = tid >> 6, lane = tid & 63;
    for (int it = bid; it < 288; it += G) p0_mod_item(a, lds, it, tid);
    { f32x2* rt = (f32x2*)(ws_ + WS_ROPE);
      for (int e = bid * NTHREADS + tid; e < 2056 * 32; e += G * NTHREADS) { const int pi = e >> 5, i = e & 31; const int pos = pi < SEQ ? pi : PAST + (pi - SEQ);
          const float ang = (float)pos * INV_FREQ[i]; const double rv = (double)ang * 0.15915494309189535; const float f = (float)(rv - rint(rv));
          f32x2 cs; cs.x = __builtin_amdgcn_cosf(f); cs.y = __builtin_amdgcn_sinf(f); rt[e] = cs; } }
    LAS float* scr = (LAS float*)(lds + wave * 16384);
    const int gw = bid * 8 + wave, NGW = G * 8;
    constexpr int I_IN = 16 * 320, I_GM = 16 * 32, I_ATT = 8 * 32, I_O = 16 * 32, I_L = I_IN + I_GM + I_ATT + I_O;
    for (int it = gw; it < 2 * I_L; it += NGW) {
        const int l = it / I_L; int r = it % I_L;
        if (r < I_IN) { p0_transpose_item(w_in_ + (size_t)l * 1024 * NPROJ, 1024, NPROJ, (bf16*)(ws_ + WS_WTIN) + (size_t)l * NPROJ * 1024, scr, r, lane); continue; } r -= I_IN;
        if (r < I_GM) { p0_transpose_item(w_gm_out_ + (size_t)l * 1024 * 1024, 1024, 1024, (bf16*)(ws_ + WS_WTGM) + (size_t)l * 1024 * 1024, scr, r, lane); continue; } r -= I_GM;
        if (r < I_ATT) { p0_transpose_item(w_att_out_ + (size_t)l * 512 * 1024, 512, 1024, (bf16*)(ws_ + WS_WTATT) + (size_t)l * 1024 * 512, scr, r, lane); continue; } r -= I_ATT;
        p0_transpose_item(w_o_ + (size_t)l * 1024 * 1024, 1024, 1024, (bf16*)(ws_ + WS_WTO) + (size_t)l * 1024 * 1024, scr, r, lane);
    }
}

__device__ __forceinline__ void norm_phase(const PT& a, int l  , const float* xbuf  , int tid, int bid, int G) {
    const float* x_prompt_ = a.x_prompt(); const float* x_sample_ = a.x_sample(); const float* norm_g_ = a.norm_g(); const float* final_g_ = a.final_g(); float* out_ = a.out(); unsigned char* ws_ = a.ws();
    const int wave = tid >> 6, lane = tid & 63; const int gw = bid * 8 + wave, NGW = G * 8;
    const float* mod = (const float*)(ws_ + WS_MOD);
    bf16* H = (bf16*)(ws_ + WS_H);
    for (int m = gw; m < MROWS; m += NGW) {
        const float* xr = xbuf ? xbuf + (size_t)m * 1024 : (m < MP ? x_prompt_ + (size_t)m * 1024 : x_sample_ + (size_t)(m - MP) * 1024);
        f32x4 v[4]; float ss = 0.f;
#pragma unroll
        for (int j = 0; j < 4; ++j) { v[j] = *(const f32x4*)(xr + 4 * lane + 256 * j); ss += (v[j][0] * v[j][0] + v[j][1] * v[j][1]) + (v[j][2] * v[j][2] + v[j][3] * v[j][3]); }
        const float rstd = 1.0f / sqrtf(wave_sum(ss) * (1.0f / 1024.0f) + 1e-6f);
        if (l < 2) {
            const float* mr = mod + ((size_t)l * NCOND + cond_row(m)) * 3072;
#pragma unroll
            for (int j = 0; j < 4; ++j) { const int c = 4 * lane + 256 * j; const f32x4 g = *(const f32x4*)(norm_g_ + l * 1024 + c), sh = *(const f32x4*)(mr + c), sc = *(const f32x4*)(mr + 1024 + c);
                const f32x4 h = (v[j] * rstd) * g * (sc + 1.0f) + sh; u32x2 w; w.x = pk2(h[0], h[1]); w.y = pk2(h[2], h[3]); *(u32x2*)(H + (size_t)m * 1024 + c) = w; }
        } else {
#pragma unroll
            for (int j = 0; j < 4; ++j) { const int c = 4 * lane + 256 * j; const f32x4 g = *(const f32x4*)(final_g_ + c); *(f32x4*)(out_ + O_Y + (size_t)m * 1024 + c) = (v[j] * rstd) * g; }
        }
    }
}

__device__ __forceinline__ float* kv_out_ptr(float* out_, int l, int m, int g, int kvsel) {
    if (m >= MP) { const int r = m - MP; const size_t off = (g == 0 ? O_KVS0 : g == 1 ? O_KVS1 : O_KVS2); return out_ + off + (((size_t)l * MS + r) * 2 + kvsel) * 512; }
    const int b = m >> 11, t = m & 2047; const int nk = g == 0 ? 128 : g == 1 ? 512 : 2048; const int i = t - (SEQ - nk); if (i < 0) return nullptr;
    const size_t off = (g == 0 ? O_KVP0 : g == 1 ? O_KVP1 : O_KVP2); return out_ + off + ((((size_t)l * NBATCH + b) * nk + i) * 2 + kvsel) * 512;
}
__device__ __forceinline__ void p2a_phase(const PT& a, int l, int tid, int bid, int G) {
    const float* gm_ln_g_ = a.gm_ln_g(); const float* gm_ln_b_ = a.gm_ln_b(); float* out_ = a.out(); unsigned char* ws_ = a.ws();
    const int wave = tid >> 6, lane = tid & 63; const int gw = bid * 8 + wave, NGW = G * 8;
    bf16* P = (bf16*)(ws_ + WS_PROJ);
    const f32x2* rt = (const f32x2*)(ws_ + WS_ROPE);
    for (int m = gw; m < MROWS; m += NGW) {
        bf16* pr = P + (size_t)m * NPROJ;
        { float gv[16]; float s = 0.f;
#pragma unroll
          for (int j = 0; j < 2; ++j) { const u32x4 w = *(const u32x4*)(pr + C_V + 8 * lane + 512 * j);
              gv[8 * j + 0] = geluf_(bflo(w.x)); gv[8 * j + 1] = geluf_(bfhi(w.x)); gv[8 * j + 2] = geluf_(bflo(w.y)); gv[8 * j + 3] = geluf_(bfhi(w.y));
              gv[8 * j + 4] = geluf_(bflo(w.z)); gv[8 * j + 5] = geluf_(bfhi(w.z)); gv[8 * j + 6] = geluf_(bflo(w.w)); gv[8 * j + 7] = geluf_(bfhi(w.w)); }
#pragma unroll
          for (int i = 0; i < 16; ++i) s += gv[i];
          const float mu = wave_sum(s) * (1.0f / 1024.0f); float q = 0.f;
#pragma unroll
          for (int i = 0; i < 16; ++i) { gv[i] -= mu; q += gv[i] * gv[i]; }
          const float rstd = 1.0f / sqrtf(wave_sum(q) * (1.0f / 1024.0f) + 1e-5f);
#pragma unroll
          for (int j = 0; j < 2; ++j) { const int c = 8 * lane + 512 * j; float o[8];
#pragma unroll
              for (int i = 0; i < 8; ++i) o[i] = gv[8 * j + i] * rstd * gm_ln_g_[l * 1024 + c + i] + gm_ln_b_[l * 1024 + c + i];
              u32x4 w; w.x = pk2(o[0], o[1]); w.y = pk2(o[2], o[3]); w.z = pk2(o[4], o[5]); w.w = pk2(o[6], o[7]); *(u32x4*)(pr + C_V + c) = w;
              if (m >= MP) { float* go = out_ + O_GMV + ((size_t)l * MS + (m - MP)) * 1024 + c; *(f32x4*)go = (f32x4){o[0], o[1], o[2], o[3]}; *(f32x4*)(go + 4) = (f32x4){o[4], o[5], o[6], o[7]}; } } }
        { const int pi = m < MP ? (m & 2047) : SEQ + ((m - MP) & 7); const f32x2 cs = rt[pi * 32 + (lane & 31)];
          for (int hh = 0; hh < 24; ++hh) { const int head = 2 * hh + (lane >> 5);
              bf16* hp = pr + C_Q + head * 64 + (lane & 31); const float x1 = bf2f(hp[0]), x2 = bf2f(hp[32]);
              const float o1 = x1 * cs.x - x2 * cs.y, o2 = x2 * cs.x + x1 * cs.y; hp[0] = (bf16)f2bf(o1); hp[32] = (bf16)f2bf(o2);
              if (head >= 24) { const int gh = head - 24, g = gh >> 3, h = gh & 7; float* ko = kv_out_ptr(out_, l, m, g, 0); if (ko) { ko[h * 64 + (lane & 31)] = o1; ko[h * 64 + 32 + (lane & 31)] = o2; } } } }
#pragma unroll
        for (int g = 0; g < 3; ++g) { float* vo = kv_out_ptr(out_, l, m, g, 1); if (vo) { const u32x4 w = *(const u32x4*)(pr + C_VAL + g * 512 + 8 * lane);
              *(f32x4*)(vo + 8 * lane) = (f32x4){bflo(w.x), bfhi(w.x), bflo(w.y), bfhi(w.y)}; *(f32x4*)(vo + 8 * lane + 4) = (f32x4){bflo(w.z), bfhi(w.z), bflo(w.w), bfhi(w.w)}; } }
    }
}

__device__ __forceinline__ void spatial_phase(const PT& a, int l, LAS unsigned char* lds, int tid, int bid, int G) {
    const float* gm_ws_ = a.gm_ws(); const float* gm_bs_ = a.gm_bs(); unsigned char* ws_ = a.ws();
    const bf16* P = (const bf16*)(ws_ + WS_PROJ); bf16* YA = (bf16*)(ws_ + WS_YA);
    LAS float* wmL = (LAS float*)lds; LAS float* vnL = (LAS float*)(lds + 65536);
    for (int it = bid; it < (256 + DBATCH) * 8; it += G) {
        const int g = it & 7, ci = it >> 3; const int m0 = ci < 256 ? ci * 128 : MP + (ci - 256) * 8, nrows = ci < 256 ? 128 : 8;
        const float* wm = gm_ws_ + ((size_t)l * 8 + g) * 16384;
        for (int e = tid; e < nrows * 128; e += NTHREADS) { wmL[e] = wm[e]; const int s = e >> 7, d = e & 127; vnL[e] = bf2f(P[(size_t)(m0 + s) * NPROJ + C_V + g * 128 + d]); }
        __syncthreads();
        const int d = tid & 127;
        for (int t = tid >> 7; t < nrows; t += 4) { float acc = 0.f;
            for (int s = 0; s <= t; ++s) acc += wmL[t * 128 + s] * vnL[s * 128 + d];
            const float y = acc + gm_bs_[((size_t)l * 8 + g) * 128 + t]; const size_t m = (size_t)(m0 + t); const int col = g * 128 + d;
            const float u = bf2f(P[m * NPROJ + C_U + col]), za = bf2f(P[m * NPROJ + C_ZA + col]);
            YA[m * 1024 + col] = (bf16)f2bf(geluf_(u) * y * siluf_(za)); }
        __syncthreads();
    }
}

typedef short bf16x8_t __attribute__((ext_vector_type(8)));
typedef float f32x16 __attribute__((ext_vector_type(16)));
typedef short s16x4_t __attribute__((ext_vector_type(4)));
__device__ __forceinline__ int crow(int j, int hi) { return (j & 3) + 8 * (j >> 2) + 4 * hi; }
__device__ __forceinline__ unsigned cvtpk(float lo, float hi) { unsigned r; asm volatile("v_cvt_pk_bf16_f32 %0, %1, %2" : "=v"(r) : "v"(lo), "v"(hi)); return r; }
__device__ __forceinline__ s16x4_t vtr(LAS const unsigned char* p) { return __builtin_bit_cast(s16x4_t, __builtin_amdgcn_ds_read_tr16_b64_v4i16((LAS s16x4_t*)p)); }
constexpr float ATT_SCALE2 = 0.125f * 1.4426950408889634f;

template <int NT> __device__ __forceinline__ void attn_unit(const bf16* Qb, const bf16* Kb, const bf16* Vb, int pitch, int dil, int r, int qt, bf16* Og, float* Lg, LAS unsigned char* vst, int lane) {
    const int q32 = lane & 31, hi = lane >> 5;
    const size_t qtok = (size_t)((32 * qt + q32) * dil + r);
    bf16x8_t qf[4];
#pragma unroll
    for (int ks = 0; ks < 4; ++ks) qf[ks] = *(const bf16x8_t*)(Qb + qtok * pitch + 16 * ks + 8 * hi);
    f32x16 st[NT];
#pragma unroll
    for (int ti = 0; ti < NT; ++ti) { const int kt = qt - (NT - 1) + ti;
        const bf16* kp = Kb + (size_t)((32 * kt + q32) * dil + r) * pitch + 8 * hi;
        const bf16x8_t k0 = *(const bf16x8_t*)kp, k1 = *(const bf16x8_t*)(kp + 16), k2 = *(const bf16x8_t*)(kp + 32), k3 = *(const bf16x8_t*)(kp + 48);
        f32x16 acc;
#pragma unroll
        for (int j = 0; j < 16; ++j) acc[j] = 0.f;
        acc = __builtin_amdgcn_mfma_f32_32x32x16_bf16(k0, qf[0], acc, 0, 0, 0); acc = __builtin_amdgcn_mfma_f32_32x32x16_bf16(k1, qf[1], acc, 0, 0, 0);
        acc = __builtin_amdgcn_mfma_f32_32x32x16_bf16(k2, qf[2], acc, 0, 0, 0); acc = __builtin_amdgcn_mfma_f32_32x32x16_bf16(k3, qf[3], acc, 0, 0, 0);
#pragma unroll
        for (int j = 0; j < 16; ++j) { const int cr = crow(j, hi); bool valid = true;
            if (NT == 5 && ti == 0) valid = cr >= q32;
            if (ti == NT - 1) valid = valid && (cr <= q32);
            st[ti][j] = valid ? acc[j] * ATT_SCALE2 : -1e30f; }
    }
    float mx = -1e30f;
#pragma unroll
    for (int ti = 0; ti < NT; ++ti)
#pragma unroll
        for (int j = 0; j < 16; ++j) mx = fmaxf(mx, st[ti][j]);
    mx = fmaxf(mx, __shfl_xor(mx, 32));
    float lsum = 0.f;
#pragma unroll
    for (int ti = 0; ti < NT; ++ti)
#pragma unroll
        for (int j = 0; j < 16; ++j) { st[ti][j] = __builtin_amdgcn_exp2f(st[ti][j] - mx); lsum += st[ti][j]; }
    lsum += __shfl_xor(lsum, 32);
    f32x16 o[2];
#pragma unroll
    for (int j = 0; j < 16; ++j) { o[0][j] = 0.f; o[1][j] = 0.f; }
#pragma unroll
    for (int ti = 0; ti < NT; ++ti) { const int kt = qt - (NT - 1) + ti; LAS unsigned char* img = vst + (ti & 1) * 4096;
#pragma unroll
        for (int jj = 0; jj < 4; ++jj) { const int key = 8 * jj + (lane >> 3), c = lane & 7;
            const u32x4 vv = *(const u32x4*)(Vb + (size_t)((32 * kt + key) * dil + r) * pitch + 8 * c);
            *(LAS u32x4*)(img + (c >> 2) * 2048 + key * 64 + (c & 3) * 16) = vv; }
#pragma unroll
        for (int ks2 = 0; ks2 < 2; ++ks2) {
            u32x4 pw; pw.x = cvtpk(st[ti][8 * ks2 + 0], st[ti][8 * ks2 + 1]); pw.y = cvtpk(st[ti][8 * ks2 + 2], st[ti][8 * ks2 + 3]); pw.z = cvtpk(st[ti][8 * ks2 + 4], st[ti][8 * ks2 + 5]); pw.w = cvtpk(st[ti][8 * ks2 + 6], st[ti][8 * ks2 + 7]);
            const bf16x8_t pf = __builtin_bit_cast(bf16x8_t, pw);
            const int gidx = lane >> 4, qp = (lane & 15) >> 2, pp = lane & 3;
            LAS const unsigned char* rp = img + (16 * ks2 + 4 * (gidx >> 1) + qp) * 64 + (16 * (gidx & 1) + 4 * pp) * 2;
#pragma unroll
            for (int dh = 0; dh < 2; ++dh) { const s16x4_t lo = vtr(rp + dh * 2048), hi4 = vtr(rp + dh * 2048 + 8 * 64);
                const bf16x8_t vf = (bf16x8_t){lo[0], lo[1], lo[2], lo[3], hi4[0], hi4[1], hi4[2], hi4[3]};
                o[dh] = __builtin_amdgcn_mfma_f32_32x32x16_bf16(vf, pf, o[dh], 0, 0, 0); }
        }
    }
    const float inv = 1.0f / lsum; bf16* op = Og + qtok * 512;
#pragma unroll
    for (int dh = 0; dh < 2; ++dh)
#pragma unroll
        for (int j4 = 0; j4 < 4; ++j4) { u32x2 w; w.x = cvtpk(o[dh][4 * j4 + 0] * inv, o[dh][4 * j4 + 1] * inv); w.y = cvtpk(o[dh][4 * j4 + 2] * inv, o[dh][4 * j4 + 3] * inv);
            *(u32x2*)(op + 32 * dh + 8 * j4 + 4 * hi) = w; }
    if (hi == 0) Lg[qtok * 8] = (mx + __builtin_amdgcn_logf(lsum)) * 0.6931471805599453f;
}

__device__ __forceinline__ void attn_prompt_item(const PT& a, int item, LAS unsigned char* lds, int tid) {
    unsigned char* ws_ = a.ws();
    const int wave = __builtin_amdgcn_readfirstlane(tid >> 6), lane = tid & 63; const int c = item & 3, h = (item >> 2) & 7, b = item >> 5;
    const bf16* P = (const bf16*)(ws_ + WS_PROJ) + (size_t)b * SEQ * NPROJ; bf16* OG = (bf16*)(ws_ + WS_OG) + (size_t)b * SEQ * 512 + h * 64; float* LSE = (float*)(ws_ + WS_LSE) + (size_t)b * SEQ * 8 + h;
    LAS unsigned char* vst = lds + wave * 8192;
    for (int i = 0; i < 6; ++i) { const int u = wave + 8 * i, g = u >> 4, j = u & 15;
        int dil, r, qt; if (g == 0) { dil = 1; r = 0; qt = 16 * c + j; } else if (g == 1) { dil = 4; r = j >> 2; qt = 4 * c + (j & 3); } else { dil = 16; r = j; qt = c; }
        const bf16* Qb = P + C_Q + g * 512 + h * 64; const bf16* Kb = P + C_K + g * 512 + h * 64; const bf16* Vb = P + C_VAL + g * 512 + h * 64;
        bf16* Og = OG + (size_t)g * OG_STRIDE; float* Lg = LSE + (size_t)g * LSE_STRIDE;
        const int nt = qt >= 4 ? 5 : qt + 1;
        switch (nt) {
            case 1: attn_unit<1>(Qb, Kb, Vb, NPROJ, dil, r, qt, Og, Lg, vst, lane); break;
            case 2: attn_unit<2>(Qb, Kb, Vb, NPROJ, dil, r, qt, Og, Lg, vst, lane); break;
            case 3: attn_unit<3>(Qb, Kb, Vb, NPROJ, dil, r, qt, Og, Lg, vst, lane); break;
            case 4: attn_unit<4>(Qb, Kb, Vb, NPROJ, dil, r, qt, Og, Lg, vst, lane); break;
            default: attn_unit<5>(Qb, Kb, Vb, NPROJ, dil, r, qt, Og, Lg, vst, lane); break;
        }
    }
    __syncthreads();
    { const size_t t = (size_t)(512 * c + tid); const float l0 = LSE[t * 8], l1 = LSE[LSE_STRIDE + t * 8], l2 = LSE[2 * LSE_STRIDE + t * 8];
      const float mx = fmaxf(l0, fmaxf(l1, l2)); float w0 = __expf(l0 - mx), w1 = __expf(l1 - mx), w2 = __expf(l2 - mx); const float inv = 1.0f / (w0 + w1 + w2); w0 *= inv; w1 *= inv; w2 *= inv;
      const bf16* zp = P + t * NPROJ + C_ZB + h * 64; bf16* yp = (bf16*)(ws_ + WS_YB) + ((size_t)b * SEQ + t) * 512 + h * 64;
#pragma unroll 2
      for (int k8 = 0; k8 < 8; ++k8) {
          const u32x4 a0 = *(const u32x4*)(OG + t * 512 + 8 * k8), a1 = *(const u32x4*)(OG + OG_STRIDE + t * 512 + 8 * k8), a2 = *(const u32x4*)(OG + 2 * OG_STRIDE + t * 512 + 8 * k8), zb = *(const u32x4*)(zp + 8 * k8);
          u32x4 o;
          o.x = pk2((w0 * bflo(a0.x) + w1 * bflo(a1.x) + w2 * bflo(a2.x)) * siluf_(bflo(zb.x)), (w0 * bfhi(a0.x) + w1 * bfhi(a1.x) + w2 * bfhi(a2.x)) * siluf_(bfhi(zb.x)));
          o.y = pk2((w0 * bflo(a0.y) + w1 * bflo(a1.y) + w2 * bflo(a2.y)) * siluf_(bflo(zb.y)), (w0 * bfhi(a0.y) + w1 * bfhi(a1.y) + w2 * bfhi(a2.y)) * siluf_(bfhi(zb.y)));
          o.z = pk2((w0 * bflo(a0.z) + w1 * bflo(a1.z) + w2 * bflo(a2.z)) * siluf_(bflo(zb.z)), (w0 * bfhi(a0.z) + w1 * bfhi(a1.z) + w2 * bfhi(a2.z)) * siluf_(bfhi(zb.z)));
          o.w = pk2((w0 * bflo(a0.w) + w1 * bflo(a1.w) + w2 * bflo(a2.w)) * siluf_(bflo(zb.w)), (w0 * bfhi(a0.w) + w1 * bfhi(a1.w) + w2 * bfhi(a2.w)) * siluf_(bfhi(zb.w)));
          *(u32x4*)(yp + 8 * k8) = o; }
    }
}

__device__ __forceinline__ void attn_sample_item(const PT& a, int l, int item, LAS unsigned char* lds, int tid) {
    unsigned char* ws_ = a.ws(); const float* cache0_ = a.cache0(); const float* cache1_ = a.cache1(); const float* cache2_ = a.cache2();
    const int wave = __builtin_amdgcn_readfirstlane(tid >> 6), lane = tid & 63; const int b = item >> 3, t = item & 7; const int h = lane >> 3, ds = (lane & 7) * 8;
    const bf16* P = (const bf16*)(ws_ + WS_PROJ); const size_t m = (size_t)MP + item;
    LAS float* PO = (LAS float*)(lds + 65536); LAS float* PM = (LAS float*)(lds + 65536 + 49152); LAS float* PL = PM + 192;
    for (int g = 0; g < 3; ++g) { const int dil = g == 0 ? 1 : g == 1 ? 4 : 16, nprev = 128 * dil;
        const float* cache = (g == 0 ? cache0_ : g == 1 ? cache1_ : cache2_) + ((size_t)l * DBATCH + b) * nprev * 1024;
        float q[8]; { const u32x4 w = *(const u32x4*)(P + m * NPROJ + C_Q + g * 512 + h * 64 + ds);
            q[0] = bflo(w.x) * ATT_SCALE2; q[1] = bfhi(w.x) * ATT_SCALE2; q[2] = bflo(w.y) * ATT_SCALE2; q[3] = bfhi(w.y) * ATT_SCALE2; q[4] = bflo(w.z) * ATT_SCALE2; q[5] = bfhi(w.z) * ATT_SCALE2; q[6] = bflo(w.w) * ATT_SCALE2; q[7] = bfhi(w.w) * ATT_SCALE2; }
        float o[8];
#pragma unroll
        for (int i = 0; i < 8; ++i) o[i] = 0.f;
        float mx = -1e30f, lsum = 0.f;
        const int j0 = wave == 0 ? 0 : 16 * wave + 1, j1 = 16 * wave + 16;
        for (int jb = j0; jb <= j1; jb += 8) {
            float kf[8][8], vf[8][8];
#pragma unroll
            for (int u = 0; u < 8; ++u) { const int j = jb + u <= j1 ? jb + u : j1; const int idx = nprev + t - dil * j;
                if (idx >= nprev) { const bf16* kp = P + ((size_t)MP + b * 8 + (idx - nprev)) * NPROJ + C_K + g * 512 + h * 64 + ds; const u32x4 kw = *(const u32x4*)kp, vw = *(const u32x4*)(kp + (C_VAL - C_K));
                    kf[u][0] = bflo(kw.x); kf[u][1] = bfhi(kw.x); kf[u][2] = bflo(kw.y); kf[u][3] = bfhi(kw.y); kf[u][4] = bflo(kw.z); kf[u][5] = bfhi(kw.z); kf[u][6] = bflo(kw.w); kf[u][7] = bfhi(kw.w);
                    vf[u][0] = bflo(vw.x); vf[u][1] = bfhi(vw.x); vf[u][2] = bflo(vw.y); vf[u][3] = bfhi(vw.y); vf[u][4] = bflo(vw.z); vf[u][5] = bfhi(vw.z); vf[u][6] = bflo(vw.w); vf[u][7] = bfhi(vw.w);
                } else { const float* kp = cache + (size_t)idx * 1024 + h * 64 + ds; const f32x4 k0 = *(const f32x4*)kp, k1 = *(const f32x4*)(kp + 4), v0 = *(const f32x4*)(kp + 512), v1 = *(const f32x4*)(kp + 516);
                    kf[u][0] = k0[0]; kf[u][1] = k0[1]; kf[u][2] = k0[2]; kf[u][3] = k0[3]; kf[u][4] = k1[0]; kf[u][5] = k1[1]; kf[u][6] = k1[2]; kf[u][7] = k1[3];
                    vf[u][0] = v0[0]; vf[u][1] = v0[1]; vf[u][2] = v0[2]; vf[u][3] = v0[3]; vf[u][4] = v1[0]; vf[u][5] = v1[1]; vf[u][6] = v1[2]; vf[u][7] = v1[3]; } }
#pragma unroll
            for (int u = 0; u < 8; ++u) { if (jb + u <= j1) {
                float s = 0.f;
#pragma unroll
                for (int i = 0; i < 8; ++i) s += q[i] * kf[u][i];
                s += __shfl_xor(s, 1); s += __shfl_xor(s, 2); s += __shfl_xor(s, 4);
                const float mn = fmaxf(mx, s), corr = __builtin_amdgcn_exp2f(mx - mn), p = __builtin_amdgcn_exp2f(s - mn); mx = mn; lsum = lsum * corr + p;
#pragma unroll
                for (int i = 0; i < 8; ++i) o[i] = o[i] * corr + p * vf[u][i]; } }
        }
        const int pi = g * 8 + wave;
        *(LAS f32x4*)(PO + pi * 512 + lane * 8) = (f32x4){o[0], o[1], o[2], o[3]}; *(LAS f32x4*)(PO + pi * 512 + lane * 8 + 4) = (f32x4){o[4], o[5], o[6], o[7]};
        if ((lane & 7) == 0) { PM[pi * 8 + h] = mx; PL[pi * 8 + h] = lsum; }
    }
    __syncthreads();
    { const int hh = tid >> 6; float M = -1e30f;
#pragma unroll
      for (int p = 0; p < 24; ++p) M = fmaxf(M, PM[p * 8 + hh]);
      float L = 0.f, acc = 0.f;
#pragma unroll
      for (int p = 0; p < 24; ++p) { const float w = __builtin_amdgcn_exp2f(PM[p * 8 + hh] - M); L += w * PL[p * 8 + hh]; acc += w * PO[p * 512 + tid]; }
      const float zb = bf2f(P[m * NPROJ + C_ZB + tid]);
      ((bf16*)(ws_ + WS_YB))[m * 512 + tid] = (bf16)f2bf(acc / L * siluf_(zb)); }
    __syncthreads();
}

__device__ __forceinline__ void attn_phase(const PT& a, int l, LAS unsigned char* lds, int tid, int bid, int G) {
    for (int it = bid; it < MS; it += G) attn_sample_item(a, l, it, lds, tid);
    for (int it = bid; it < NBATCH * 8 * 4; it += G) attn_prompt_item(a, it, lds, tid);
}


__global__ void __launch_bounds__(NTHREADS, 2) hybrid_step_fwd(Args ka) {
    extern __shared__ __attribute__((aligned(16))) unsigned char lds_raw[];
    LAS unsigned char* lds = (LAS unsigned char*)lds_raw;
    cg::grid_group grid = cg::this_grid();
    const int bid = blockIdx.x, G = gridDim.x;
    { LAS unsigned long long* pt = (LAS unsigned long long*)(lds + PTAB_OFF);
      if (threadIdx.x == 0) { pt[0] = (unsigned long long)ka.x_prompt; pt[1] = (unsigned long long)ka.x_sample; pt[2] = (unsigned long long)ka.cache0; pt[3] = (unsigned long long)ka.cache1; pt[4] = (unsigned long long)ka.cache2;
          pt[5] = (unsigned long long)ka.c_prompt; pt[6] = (unsigned long long)ka.c_sample; pt[7] = (unsigned long long)ka.w_ada; pt[8] = (unsigned long long)ka.b_ada; pt[9] = (unsigned long long)ka.norm_g;
          pt[10] = (unsigned long long)ka.w_in; pt[11] = (unsigned long long)ka.gm_ln_g; pt[12] = (unsigned long long)ka.gm_ln_b; pt[13] = (unsigned long long)ka.gm_ws; pt[14] = (unsigned long long)ka.gm_bs;
          pt[15] = (unsigned long long)ka.w_gm_out; pt[16] = (unsigned long long)ka.w_att_out; pt[17] = (unsigned long long)ka.w_o; pt[18] = (unsigned long long)ka.final_g; pt[19] = (unsigned long long)ka.out; pt[20] = (unsigned long long)ka.ws; }
      __syncthreads(); }
    PT a; a.t = (LAS const unsigned long long*)(lds + PTAB_OFF);
#define TID() ({ int t_ = threadIdx.x; asm volatile("" : "+v"(t_)); t_; })
#define WSP(T, off) ((T*)(a.ws() + (off)))

    p0_phase(a, lds, TID(), bid, G);
    grid.sync();
    norm_phase(a, 0, nullptr, TID(), bid, G);
    grid.sync();
    for (int l = 0; l < 2; ++l) {
        { pg8::Gemm g{WSP(bf16, WS_H), WSP(bf16, WS_WTIN) + (size_t)l * NPROJ * 1024, MROWS, NPROJ, 1024}; pg8::StaticOrder S; S.init(MROWS, NPROJ, G, bid);
          pg8::EpiStoreBf16 E{WSP(bf16, WS_PROJ), NPROJ}; pg8::gemm_phase<pg8::EpiStoreBf16, pg8::StaticOrder, true, true>(lds, g, S, E); }
        grid.sync();
        p2a_phase(a, l, TID(), bid, G);
        grid.sync();
        spatial_phase(a, l, lds, TID(), bid, G);
        attn_phase(a, l, lds, TID(), bid, G);
        grid.sync();
        { pg8::Gemm g{WSP(bf16, WS_YA), WSP(bf16, WS_WTGM) + (size_t)l * 1024 * 1024, MROWS, 1024, 1024}; pg8::StaticOrder S; S.init(MROWS, 1024, G, bid);
          pg8::EpiGate1 E{WSP(float, WS_T), WSP(bf16, WS_PROJ) + C_GA, NPROJ}; pg8::gemm_phase<pg8::EpiGate1, pg8::StaticOrder, true, true>(lds, g, S, E); }
        { pg8::Gemm g{WSP(bf16, WS_YB), WSP(bf16, WS_WTATT) + (size_t)l * 1024 * 512, MROWS, 1024, 512}; pg8::StaticOrder S; S.init(MROWS, 1024, G, bid);
          pg8::EpiGate2 E{WSP(float, WS_T), WSP(bf16, WS_PROJ) + C_GB, NPROJ, WSP(bf16, WS_MERGED)}; pg8::gemm_phase<pg8::EpiGate2, pg8::StaticOrder, true, true>(lds, g, S, E); }
        grid.sync();
        { pg8::Gemm g{WSP(bf16, WS_MERGED), WSP(bf16, WS_WTO) + (size_t)l * 1024 * 1024, MROWS, 1024, 1024}; pg8::StaticOrder S; S.init(MROWS, 1024, G, bid);
          float* XB = WSP(float, WS_X);
          pg8::EpiResid E{l == 0 ? a.x_prompt() : XB, l == 0 ? a.x_sample() : XB + (size_t)MP * 1024, WSP(float, WS_MOD) + (size_t)l * NCOND * 3072 + 2048, XB};
          pg8::gemm_phase<pg8::EpiResid, pg8::StaticOrder, true, true>(lds, g, S, E); }
        grid.sync();
        norm_phase(a, l + 1, WSP(float, WS_X), TID(), bid, G);
        if (l == 0) grid.sync();
    }
}

extern "C" void kernel_launch(void* const* d_in, const int* in_sizes, int n_in, void* d_out, int out_size, void* d_ws, size_t ws_size, hipStream_t stream) {
    static int grid = 0;
    if (grid == 0) {
        if (n_in != 19 || (size_t)out_size != O_TOTAL || ws_size < WS_END) { fprintf(stderr, "kernel_launch: unexpected sizes: n_in %d out %d (want %zu) ws %zu (want >= %zu)\n", n_in, out_size, (size_t)O_TOTAL, ws_size, (size_t)WS_END); grid = -1; return; }
        int dev = 0, cus = 0, per_cu = 0;
        hipGetDevice(&dev); hipDeviceGetAttribute(&cus, hipDeviceAttributeMultiprocessorCount, dev);
        if (hipFuncSetAttribute((const void*)hybrid_step_fwd, hipFuncAttributeMaxDynamicSharedMemorySize, LDS_BYTES) != hipSuccess) { fprintf(stderr, "kernel_launch: hipFuncSetAttribute failed\n"); grid = -1; return; }
        if (hipOccupancyMaxActiveBlocksPerMultiprocessor(&per_cu, (const void*)hybrid_step_fwd, NTHREADS, LDS_BYTES) != hipSuccess || per_cu < 1) { fprintf(stderr, "kernel_launch: occupancy query failed (%d)\n", per_cu); (void)hipGetLastError(); grid = -1; return; }
        grid = cus * per_cu;
        fprintf(stderr, "kernel_launch: %d CUs x %d blocks/CU -> grid %d\n", cus, per_cu, grid);
    }
    if (grid < 0) return;
    Args a{};
    a.x_prompt = (const float*)d_in[0]; a.x_sample = (const float*)d_in[1]; a.cache0 = (const float*)d_in[2]; a.cache1 = (const float*)d_in[3]; a.cache2 = (const float*)d_in[4];
    a.c_prompt = (const float*)d_in[5]; a.c_sample = (const float*)d_in[6]; a.w_ada = (const float*)d_in[7]; a.b_ada = (const float*)d_in[8]; a.norm_g = (const float*)d_in[9];
    a.w_in = (const float*)d_in[10]; a.gm_ln_g = (const float*)d_in[11]; a.gm_ln_b = (const float*)d_in[12]; a.gm_ws = (const float*)d_in[13]; a.gm_bs = (const float*)d_in[14];
    a.w_gm_out = (const float*)d_in[15]; a.w_att_out = (const float*)d_in[16]; a.w_o = (const float*)d_in[17]; a.final_g = (const float*)d_in[18];
    a.out = (float*)d_out; a.ws = (unsigned char*)d_ws;
    void* args[] = {&a};
    hipError_t e = hipLaunchCooperativeKernel((const void*)hybrid_step_fwd, dim3(grid), dim3(NTHREADS), args, LDS_BYTES, stream);
    if (e != hipSuccess) fprintf(stderr, "kernel_launch: cooperative launch failed: %s (grid %d)\n", hipGetErrorString(e), grid);
}
```

```cpp
#include <hip/hip_runtime.h>
#include <hip/hip_cooperative_groups.h>
#include <cstdio>
#include <cstdint>
#include <cmath>
namespace cg = cooperative_groups;

constexpr int D = 1024, SEQ = 2048, NBATCH = 16, MP = NBATCH * SEQ, DBATCH = 32, TDEC = 8, MS = DBATCH * TDEC, MROWS = MP + MS;
constexpr int NPROJ = 10240, NCOND = 48, PAST = 16384;
constexpr int C_U = 0, C_V = 1024, C_ZA = 2048, C_Q = 3072, C_K = 4608, C_VAL = 6144, C_ZB = 7680, C_GA = 8192, C_GB = 9216;
constexpr size_t O_Y = 0, O_KVP0 = (size_t)MROWS * 1024, O_KVP1 = O_KVP0 + 4194304, O_KVP2 = O_KVP1 + 16777216, O_KVS0 = O_KVP2 + 67108864,
                 O_KVS1 = O_KVS0 + 524288, O_KVS2 = O_KVS1 + 524288, O_GMV = O_KVS2 + 524288, O_TOTAL = O_GMV + 524288;

typedef unsigned short bf16;
typedef float f32x4 __attribute__((ext_vector_type(4)));
typedef float f32x2 __attribute__((ext_vector_type(2)));
typedef unsigned u32x4 __attribute__((ext_vector_type(4)));
typedef unsigned u32x2 __attribute__((ext_vector_type(2)));
#define LAS __attribute__((address_space(3)))

__device__ __forceinline__ float sigmoidf_(float z) { return __builtin_amdgcn_rcpf(1.0f + __builtin_amdgcn_exp2f(-1.4426950408889634f * z)); }
__device__ __forceinline__ float siluf_(float z) { return z * sigmoidf_(z); }
__device__ __forceinline__ float geluf_(float x) { return x * sigmoidf_(1.5957691216057308f * (x + 0.044715f * x * x * x)); }
__device__ __forceinline__ unsigned f2bf(float f) { unsigned u = __builtin_bit_cast(unsigned, f); return (u + 0x7fffu + ((u >> 16) & 1u)) >> 16; }
__device__ __forceinline__ unsigned pk2(float lo, float hi) { return f2bf(lo) | (f2bf(hi) << 16); }
__device__ __forceinline__ float bflo(unsigned w) { return __builtin_bit_cast(float, w << 16); }
__device__ __forceinline__ float bfhi(unsigned w) { return __builtin_bit_cast(float, w & 0xffff0000u); }
__device__ __forceinline__ float bf2f(bf16 b) { return __builtin_bit_cast(float, (unsigned)b << 16); }
__device__ __forceinline__ int cond_row(int m) { return m < MP ? (m >> 11) : NBATCH + ((m - MP) >> 3); }

namespace pg8 {
#define PG8_LAS __attribute__((address_space(3)))
typedef unsigned short bf16_t;
typedef short bf16x8 __attribute__((ext_vector_type(8)));
typedef float f32x4 __attribute__((ext_vector_type(4)));
typedef unsigned u32x4 __attribute__((ext_vector_type(4)));
constexpr int BM = 256, BK = 64, HALF = 128, HTB = HALF * BK * 2  , STAGE_BYTES = 8 * HTB, NXCD = 8, WGM = 8;

__host__ __device__ __forceinline__ int lds_byte(int r, int c) { const int st = (r >> 4) * 2 + (c >> 5), rr = r & 15, cc = c & 31, ob = rr * 64 + cc * 2; return st * 1024 + (ob ^ (((ob >> 9) & 1) << 5)); }
__host__ __device__ __forceinline__ void stage_rc(int b, int& R, int& C) { const int st = b / 1024, sb = b % 1024, swz = sb ^ (((sb >> 9) & 1) << 5); R = (st >> 1) * 16 + swz / 64; C = (st & 1) * 32 + (swz % 64) / 2; }
__host__ __device__ __forceinline__ int perm32(int rho) { const int n = rho >> 4, i = rho & 15; return 8 * (i >> 2) + 4 * n + (i & 3); }

struct Unit { int pm, pn; };
struct Gemm { const bf16_t* A; const bf16_t* Bt; int M, N, K; };

struct StaticOrder {
    int nM, nN, nwg, G, c;
    __host__ __device__ void init(int M, int N, int G_, int c_) { nM = M / BM; nN = N / BM; nwg = nM * nN; G = G_; c = c_; }
    __host__ __device__ bool next(int i, Unit& u) const {
        const long L = (long)i * G + c; if (L >= nwg) return false;
        int wgid = (int)L; { const int q = nwg / NXCD, r = nwg % NXCD, xcd = wgid % NXCD, off = wgid / NXCD; wgid = (xcd < r ? xcd * (q + 1) : r * (q + 1) + (xcd - r) * q) + off; }
        const int nig = WGM * nN, gid = wgid / nig, fm = gid * WGM, gsz = (nM - fm) < WGM ? (nM - fm) : WGM;
        u.pm = fm + ((wgid % nig) % gsz); u.pn = (wgid % nig) / gsz; return true;
    }
    __device__ __forceinline__ void a_ready(const Unit&) const {}
    __device__ __forceinline__ void done(const Unit&) const {}
};

__device__ __forceinline__ unsigned cvt_pk_bf16(float lo, float hi) { unsigned r; asm volatile("v_cvt_pk_bf16_f32 %0, %1, %2" : "=v"(r) : "v"(lo), "v"(hi)); return r; }
typedef float f32x2 __attribute__((ext_vector_type(2)));
struct EpiStoreBf16 {
    static constexpr bool PERM = true, AFTER_DRAIN = false;
    bf16_t* O; int ldc;
    __device__ __forceinline__ void operator()(const f32x4 (&acc)[2][2][4][2], const Unit& u, int wr, int wc, int fr, int fq) const {
        const int row0 = u.pm * BM + wr * 64 + fr, col0 = u.pn * BM + wc * 32 + 8 * fq;
#pragma unroll
        for (int ai = 0; ai < 2; ++ai)
#pragma unroll
            for (int m = 0; m < 4; ++m) { bf16_t* rowp = O + (size_t)(row0 + ai * HALF + m * 16) * ldc + col0;
#pragma unroll
                for (int bj = 0; bj < 2; ++bj) { const f32x4 v0 = acc[ai][bj][m][0], v1 = acc[ai][bj][m][1];
                    u32x4 w; w.x = cvt_pk_bf16(v0[0], v0[1]); w.y = cvt_pk_bf16(v0[2], v0[3]); w.z = cvt_pk_bf16(v1[0], v1[1]); w.w = cvt_pk_bf16(v1[2], v1[3]);
                    *(u32x4*)(rowp + bj * HALF) = w; } }
    }
};
struct EpiGate1 {
    static constexpr bool PERM = false, AFTER_DRAIN = false;
    float* Tq; const bf16_t* G; int ldg;
    __device__ __forceinline__ void operator()(const f32x4 (&acc)[2][2][4][2], const Unit& u, int wr, int wc, int fr, int fq) const {
        const int row0 = u.pm * BM + wr * 64 + fr, col0 = u.pn * BM + wc * 32 + 4 * fq;
#pragma unroll
        for (int ai = 0; ai < 2; ++ai)
#pragma unroll
            for (int m = 0; m < 4; ++m) { const size_t r = (size_t)(row0 + ai * HALF + m * 16);
#pragma unroll
                for (int bj = 0; bj < 2; ++bj)
#pragma unroll
                    for (int n = 0; n < 2; ++n) { const int c = col0 + bj * HALF + n * 16; const u32x2 gw = *(const u32x2*)(G + r * ldg + c);
                        f32x4 o; o[0] = ::sigmoidf_(::bflo(gw.x)) * acc[ai][bj][m][n][0]; o[1] = ::sigmoidf_(::bfhi(gw.x)) * acc[ai][bj][m][n][1];
                        o[2] = ::sigmoidf_(::bflo(gw.y)) * acc[ai][bj][m][n][2]; o[3] = ::sigmoidf_(::bfhi(gw.y)) * acc[ai][bj][m][n][3];
                        *(f32x4*)(Tq + r * 1024 + c) = o; } }
    }
};
struct EpiGate2 {
    static constexpr bool PERM = false, AFTER_DRAIN = false;
    const float* Tq; const bf16_t* G; int ldg; bf16_t* O;
    __device__ __forceinline__ void operator()(const f32x4 (&acc)[2][2][4][2], const Unit& u, int wr, int wc, int fr, int fq) const {
        const int row0 = u.pm * BM + wr * 64 + fr, col0 = u.pn * BM + wc * 32 + 4 * fq;
#pragma unroll
        for (int ai = 0; ai < 2; ++ai)
#pragma unroll
            for (int m = 0; m < 4; ++m) { const size_t r = (size_t)(row0 + ai * HALF + m * 16);
#pragma unroll
                for (int bj = 0; bj < 2; ++bj)
#pragma unroll
                    for (int n = 0; n < 2; ++n) { const int c = col0 + bj * HALF + n * 16; const u32x2 gw = *(const u32x2*)(G + r * ldg + c); const f32x4 t = *(const f32x4*)(Tq + r * 1024 + c);
                        const float o0 = t[0] + ::sigmoidf_(::bflo(gw.x)) * acc[ai][bj][m][n][0], o1 = t[1] + ::sigmoidf_(::bfhi(gw.x)) * acc[ai][bj][m][n][1];
                        const float o2 = t[2] + ::sigmoidf_(::bflo(gw.y)) * acc[ai][bj][m][n][2], o3 = t[3] + ::sigmoidf_(::bfhi(gw.y)) * acc[ai][bj][m][n][3];
                        u32x2 w; w.x = cvt_pk_bf16(o0, o1); w.y = cvt_pk_bf16(o2, o3); *(u32x2*)(O + r * 1024 + c) = w; } }
    }
};
struct EpiResid {
    static constexpr bool PERM = false, AFTER_DRAIN = false;
    const float* xp; const float* xs; const float* gate  ; float* xo;
    __device__ __forceinline__ void operator()(const f32x4 (&acc)[2][2][4][2], const Unit& u, int wr, int wc, int fr, int fq) const {
        const int row0 = u.pm * BM + wr * 64 + fr, col0 = u.pn * BM + wc * 32 + 4 * fq;
#pragma unroll
        for (int ai = 0; ai < 2; ++ai)
#pragma unroll
            for (int m = 0; m < 4; ++m) { const int r = row0 + ai * HALF + m * 16; const float* xr = r < ::MP ? xp + (size_t)r * 1024 : xs + (size_t)(r - ::MP) * 1024;
                const float* gr = gate + (size_t)::cond_row(r) * 3072;
#pragma unroll
                for (int bj = 0; bj < 2; ++bj)
#pragma unroll
                    for (int n = 0; n < 2; ++n) { const int c = col0 + bj * HALF + n * 16; const f32x4 xv = *(const f32x4*)(xr + c), gv = *(const f32x4*)(gr + c);
                        *(f32x4*)(xo + (size_t)r * 1024 + c) = xv + gv * acc[ai][bj][m][n]; } }
    }
};
template <class Epi, class Sched, bool ALIGN_EPI = false, bool SP2 = false>
__device__ __forceinline__ void gemm_phase(PG8_LAS unsigned char* lds, const Gemm g, const Sched& S, const Epi& E) {
    int tid_ = threadIdx.x; asm volatile("" : "+v"(tid_));
    const int tid = tid_, wid = __builtin_amdgcn_readfirstlane(tid >> 6), lane = tid & 63, wr = wid >> 2, wc = wid & 3, fr = lane & 15, fq = lane >> 4;
    const int K = g.K, nt = K / BK;
    unsigned voffA[2], voffB[2];
#pragma unroll
    for (int i = 0; i < 2; ++i) { int R, C; stage_rc(tid * 16 + i * 8192, R, C); const int Rb = Epi::PERM ? ((R & ~31) + perm32(R & 31)) : R;
        voffA[i] = (unsigned)(R * K + C) * 2u; voffB[i] = (unsigned)(Rb * K + C) * 2u; }
    const size_t kstep = (size_t)(BK * 2);
    const size_t hstep = (size_t)HALF * K * 2;
    const size_t tstep = 2 * hstep;
    const unsigned ldsw = (unsigned)wid * 1024u;
    const int aoff = lds_byte(wr * 64 + fr, fq * 8), boff = lds_byte(wc * 32 + fr, fq * 8);
#define PG8_SA(b, h) (((b) * 2 + (h)) * HTB)
#define PG8_SB(b, h) ((4 + (b) * 2 + (h)) * HTB)
#define PG8_STAGE(bufoff, gbase, voff) do { _Pragma("unroll") for (int _i = 0; _i < 2; ++_i) \
        __builtin_amdgcn_global_load_lds((const unsigned*)((const char*)(gbase) + (voff)[_i]), (PG8_LAS unsigned*)(lds + (bufoff) + ldsw + _i * 8192), 16, 0, 0); } while (0)
#define PG8_LDA(dst, b, h) do { _Pragma("unroll") for (int m = 0; m < 4; ++m) _Pragma("unroll") for (int k = 0; k < 2; ++k) dst[m][k] = *(const PG8_LAS bf16x8*)(lds + PG8_SA(b, h) + aoff + m * 2048 + k * 1024); } while (0)
#define PG8_LDB(dst, b, h) do { _Pragma("unroll") for (int n = 0; n < 2; ++n) _Pragma("unroll") for (int k = 0; k < 2; ++k) dst[n][k] = *(const PG8_LAS bf16x8*)(lds + PG8_SB(b, h) + boff + n * 2048 + k * 1024); } while (0)
#define PG8_MMA(ai, bj, At, Bt) do { __builtin_amdgcn_s_setprio(1); _Pragma("unroll") for (int m = 0; m < 4; ++m) _Pragma("unroll") for (int n = 0; n < 2; ++n) _Pragma("unroll") for (int k = 0; k < 2; ++k) \
        acc[ai][bj][m][n] = __builtin_amdgcn_mfma_f32_16x16x32_bf16(Bt[n][k], At[m][k], acc[ai][bj][m][n], 0, 0, 0); __builtin_amdgcn_s_setprio(0); } while (0)
#define PG8_WAIT_V(n) asm volatile("s_waitcnt vmcnt(" #n ")" ::: "memory")
#define PG8_WAIT_L(n) asm volatile("s_waitcnt lgkmcnt(" #n ")" ::: "memory")
#define PG8_BAR __builtin_amdgcn_s_barrier()
#define PG8_SCHED __builtin_amdgcn_sched_barrier(0)
    Unit cur, nxt; int ui = 0;
    if (!S.next(0, cur)) return;
    f32x4 acc[2][2][4][2];
#pragma unroll
    for (int a = 0; a < 2; ++a)
#pragma unroll
        for (int b = 0; b < 2; ++b)
#pragma unroll
            for (int m = 0; m < 4; ++m)
#pragma unroll
                for (int n = 0; n < 2; ++n) acc[a][b][m][n] = (f32x4){0.f, 0.f, 0.f, 0.f};
    bf16x8 At[4][2], B0[2][2], B1[2][2];
    const char* cA = (const char*)g.A + (size_t)cur.pm * tstep; const char* cB = (const char*)g.Bt + (size_t)cur.pn * tstep;
    S.a_ready(cur);
    if constexpr (SP2) {
        PG8_STAGE(PG8_SB(0, 0), cB, voffB); PG8_STAGE(PG8_SB(0, 1), cB + hstep, voffB); PG8_STAGE(PG8_SA(0, 0), cA, voffA); PG8_STAGE(PG8_SA(0, 1), cA + hstep, voffA);
        if (wr == 1) PG8_BAR;
        PG8_WAIT_V(2); PG8_BAR;
        PG8_STAGE(PG8_SB(1, 0), cB + kstep, voffB); PG8_STAGE(PG8_SA(1, 0), cA + kstep, voffA); PG8_STAGE(PG8_SB(1, 1), cB + hstep + kstep, voffB);
        PG8_WAIT_V(6); PG8_BAR;
    } else {
        PG8_STAGE(PG8_SB(0, 0), cB, voffB); PG8_STAGE(PG8_SA(0, 0), cA, voffA); PG8_STAGE(PG8_SB(0, 1), cB + hstep, voffB); PG8_STAGE(PG8_SA(0, 1), cA + hstep, voffA);
        if (wr == 1) PG8_BAR;
        PG8_WAIT_V(4); PG8_BAR;
        PG8_STAGE(PG8_SB(1, 0), cB + kstep, voffB); PG8_STAGE(PG8_SA(1, 0), cA + kstep, voffA); PG8_STAGE(PG8_SB(1, 1), cB + hstep + kstep, voffB);
        PG8_WAIT_V(6); PG8_BAR;
    }
    for (;;) {
        const bool has_next = S.next(ui + 1, nxt);
        const char* nA = has_next ? (const char*)g.A + (size_t)nxt.pm * tstep : cA; const char* nB = has_next ? (const char*)g.Bt + (size_t)nxt.pn * tstep : cB;
        for (int t = 0; t < nt; t += 2) {
            const bool last = (t == nt - 2);
            const char* a1 = cA + (size_t)(t + 1) * kstep;
            const char* a2 = last ? nA : cA + (size_t)(t + 2) * kstep; const char* b2 = last ? nB : cB + (size_t)(t + 2) * kstep;
            const char* a3 = a2 + kstep; const char* b3 = b2 + kstep;
            if (last && has_next) S.a_ready(nxt);
            if constexpr (SP2) {
            PG8_LDB(B0, 0, 0); PG8_LDB(B1, 0, 1); PG8_SCHED; PG8_LDA(At, 0, 0); PG8_STAGE(PG8_SA(1, 1), a1 + hstep, voffA);
            PG8_WAIT_V(8); PG8_WAIT_L(0); PG8_BAR; PG8_MMA(0, 0, At, B0); PG8_MMA(0, 1, At, B1); PG8_BAR; PG8_SCHED;
            PG8_LDA(At, 0, 1); PG8_STAGE(PG8_SB(0, 0), b2, voffB); PG8_STAGE(PG8_SB(0, 1), b2 + hstep, voffB); PG8_STAGE(PG8_SA(0, 0), a2, voffA);
            PG8_WAIT_V(8); PG8_WAIT_L(0); PG8_BAR; PG8_MMA(1, 0, At, B0); PG8_MMA(1, 1, At, B1); PG8_BAR; PG8_SCHED;
            PG8_LDB(B0, 1, 0); PG8_LDB(B1, 1, 1); PG8_SCHED; PG8_LDA(At, 1, 0); PG8_STAGE(PG8_SA(0, 1), a2 + hstep, voffA);
            PG8_WAIT_V(8); PG8_WAIT_L(0); PG8_BAR; PG8_MMA(0, 0, At, B0); PG8_MMA(0, 1, At, B1); PG8_BAR; PG8_SCHED;
            PG8_LDA(At, 1, 1); PG8_STAGE(PG8_SB(1, 0), b3, voffB); PG8_STAGE(PG8_SB(1, 1), b3 + hstep, voffB); PG8_STAGE(PG8_SA(1, 0), a3, voffA);
            PG8_WAIT_V(8); PG8_WAIT_L(0); PG8_BAR; PG8_MMA(1, 0, At, B0); PG8_MMA(1, 1, At, B1); PG8_BAR; PG8_SCHED;
            } else {
            PG8_LDB(B0, 0, 0); PG8_SCHED; PG8_LDA(At, 0, 0); PG8_STAGE(PG8_SA(1, 1), a1 + hstep, voffA);
            PG8_WAIT_L(8); PG8_BAR; PG8_WAIT_L(0); PG8_MMA(0, 0, At, B0); PG8_BAR; PG8_SCHED;
            PG8_LDB(B1, 0, 1); PG8_STAGE(PG8_SB(0, 0), b2, voffB);
            PG8_BAR; PG8_WAIT_L(0); PG8_MMA(0, 1, At, B1); PG8_BAR;
            PG8_LDA(At, 0, 1); PG8_STAGE(PG8_SA(0, 0), a2, voffA);
            PG8_BAR; PG8_WAIT_L(0); PG8_MMA(1, 0, At, B0); PG8_BAR; PG8_SCHED;
            PG8_STAGE(PG8_SB(0, 1), b2 + hstep, voffB);
            PG8_WAIT_V(6); PG8_BAR; PG8_MMA(1, 1, At, B1); PG8_BAR;
            PG8_LDB(B0, 1, 0); PG8_SCHED; PG8_LDA(At, 1, 0); PG8_STAGE(PG8_SA(0, 1), a2 + hstep, voffA);
            PG8_WAIT_L(8); PG8_BAR; PG8_WAIT_L(0); PG8_MMA(0, 0, At, B0); PG8_BAR; PG8_SCHED;
            PG8_LDB(B1, 1, 1); PG8_STAGE(PG8_SB(1, 0), b3, voffB);
            PG8_BAR; PG8_WAIT_L(0); PG8_MMA(0, 1, At, B1); PG8_BAR;
            PG8_LDA(At, 1, 1); PG8_STAGE(PG8_SA(1, 0), a3, voffA);
            PG8_BAR; PG8_WAIT_L(0); PG8_MMA(1, 0, At, B0); PG8_BAR; PG8_SCHED;
            PG8_STAGE(PG8_SB(1, 1), b3 + hstep, voffB);
            PG8_WAIT_V(6); PG8_BAR; PG8_MMA(1, 1, At, B1); PG8_BAR;
            }
        }
        if constexpr (ALIGN_EPI) { if (wr == 0) PG8_BAR; }
        if constexpr (!Epi::AFTER_DRAIN) { E(acc, cur, wr, wc, fr, fq); S.done(cur); }
        if (!has_next) break;
#pragma unroll
        for (int a = 0; a < 2; ++a)
#pragma unroll
            for (int b = 0; b < 2; ++b)
#pragma unroll
                for (int m = 0; m < 4; ++m)
#pragma unroll
                    for (int n = 0; n < 2; ++n) acc[a][b][m][n] = (f32x4){0.f, 0.f, 0.f, 0.f};
        cur = nxt; cA = nA; cB = nB; ++ui;
        if constexpr (ALIGN_EPI) { if (wr == 1) PG8_BAR; }
    }
    PG8_WAIT_V(0);
    if constexpr (!ALIGN_EPI) { if (wr == 0) PG8_BAR; }
    PG8_BAR;
    if constexpr (Epi::AFTER_DRAIN) { E.fused(acc, cur, wr, wc, fr, fq, lds, wid, lane); S.done(cur); }
#undef PG8_SA
#undef PG8_SB
#undef PG8_STAGE
#undef PG8_LDA
#undef PG8_LDB
#undef PG8_MMA
#undef PG8_WAIT_V
#undef PG8_WAIT_L
#undef PG8_BAR
#undef PG8_SCHED
}
}

constexpr size_t MiB = 1u << 20;
constexpr size_t WS_MOD = 1 * MiB, WS_ROPE = 3 * MiB, WS_WTIN = 4 * MiB, WS_WTGM = 44 * MiB, WS_WTATT = 48 * MiB, WS_WTO = 50 * MiB, WS_WMB = 55 * MiB,
                 WS_H = 56 * MiB, WS_YA = 122 * MiB, WS_YB = 188 * MiB, WS_OG = 222 * MiB, WS_LSE = 320 * MiB, WS_MERGED = 324 * MiB,
                 WS_T = 390 * MiB, WS_X = 520 * MiB, WS_PROJ = 650 * MiB, WS_END = 1296 * MiB;
constexpr size_t OG_STRIDE = (size_t)MROWS * 512;
constexpr size_t LSE_STRIDE = (size_t)MROWS * 8;
constexpr int LDS_BYTES = 147456;
constexpr int NTHREADS = 512;

struct Args {
    const float* x_prompt; const float* x_sample; const float* cache0; const float* cache1; const float* cache2; const float* c_prompt; const float* c_sample;
    const float* w_ada; const float* b_ada; const float* norm_g; const float* w_in; const float* gm_ln_g; const float* gm_ln_b; const float* gm_ws; const float* gm_bs;
    const float* w_gm_out; const float* w_att_out; const float* w_o; const float* final_g;
    float* out; unsigned char* ws;
};
constexpr int PTAB_OFF = 131072 + 1024;
struct PT {
    LAS const unsigned long long* t;
    __device__ __forceinline__ unsigned long long g(int i) const { const unsigned long long v = t[i]; const unsigned lo = __builtin_amdgcn_readfirstlane((unsigned)v), hi = __builtin_amdgcn_readfirstlane((unsigned)(v >> 32)); return ((unsigned long long)hi << 32) | lo; }
#define GASP(v) ((__attribute__((address_space(1))) unsigned char*)(v))
#define PTF(name, idx) __device__ __forceinline__ const float* name() const { return (const float*)GASP(g(idx)); }
    PTF(x_prompt, 0) PTF(x_sample, 1) PTF(cache0, 2) PTF(cache1, 3) PTF(cache2, 4) PTF(c_prompt, 5) PTF(c_sample, 6) PTF(w_ada, 7) PTF(b_ada, 8) PTF(norm_g, 9) PTF(w_in, 10)
    PTF(gm_ln_g, 11) PTF(gm_ln_b, 12) PTF(gm_ws, 13) PTF(gm_bs, 14) PTF(w_gm_out, 15) PTF(w_att_out, 16) PTF(w_o, 17) PTF(final_g, 18)
#undef PTF
    __device__ __forceinline__ float* out() const { return (float*)GASP(g(19)); }
    __device__ __forceinline__ unsigned char* ws() const { return (unsigned char*)GASP(g(20)); }
};
__device__ const float INV_FREQ[32] = {1.000000000e+00f, 7.498942614e-01f, 5.623413324e-01f, 4.216965139e-01f, 3.162277639e-01f, 2.371373773e-01f, 1.778279394e-01f, 1.333521307e-01f, 1.000000015e-01f, 7.498941571e-02f, 5.623413250e-02f, 4.216965288e-02f, 3.162277490e-02f, 2.371373773e-02f, 1.778279431e-02f, 1.333521493e-02f, 9.999999776e-03f, 7.498941850e-03f, 5.623413250e-03f, 4.216964822e-03f, 3.162277630e-03f, 2.371373586e-03f, 1.778279431e-03f, 1.333521446e-03f, 1.000000047e-03f, 7.498942432e-04f, 5.623413017e-04f, 4.216965172e-04f, 3.162277571e-04f, 2.371373703e-04f, 1.778279402e-04f, 1.333521504e-04f};

__device__ __forceinline__ float wave_sum(float v) {
#pragma unroll
    for (int o = 1; o < 64; o <<= 1) v += __shfl_xor(v, o);
    return v;
}

__device__ __forceinline__ void p0_transpose_item(const float* W, int K, int N, bf16* WT, LAS float* scr, int item, int lane) {
    const int nblk = N / 32, kb = item / nblk, nb = item % nblk, k0 = 64 * kb, n0 = 32 * nb;
#pragma unroll 8
    for (int i = 0; i < 32; ++i) { const int kk = 2 * i + (lane >> 5); scr[kk * 33 + (lane & 31)] = W[(size_t)(k0 + kk) * N + n0 + (lane & 31)]; }
    asm volatile("s_waitcnt lgkmcnt(0)" ::: "memory");
    const int c = lane & 7;
#pragma unroll
    for (int j = 0; j < 4; ++j) { const int n = (lane >> 3) + 8 * j; const LAS float* s = scr + (8 * c) * 33 + n;
        u32x4 o; o.x = pk2(s[0 * 33], s[1 * 33]); o.y = pk2(s[2 * 33], s[3 * 33]); o.z = pk2(s[4 * 33], s[5 * 33]); o.w = pk2(s[6 * 33], s[7 * 33]);
        *(u32x4*)(WT + (size_t)(n0 + n) * K + k0 + 8 * c) = o; }
    asm volatile("s_waitcnt lgkmcnt(0)" ::: "memory");
}

__device__ __forceinline__ void p0_mod_item(const PT& a, LAS unsigned char* lds, int item, int tid) {
    const float* c_prompt_ = a.c_prompt(); const float* c_sample_ = a.c_sample(); const float* w_ada_ = a.w_ada(); const float* b_ada_ = a.b_ada(); unsigned char* ws_ = a.ws();
    const int wave = tid >> 6, lane = tid & 63;
    const int rg = item % 3; const int r2 = item / 3; const int cb = r2 % 48; const int l = r2 / 48;
    const int row0 = rg * 16, col = cb * 64 + lane, k0 = wave * 128;
    LAS float* tab = (LAS float*)(lds + wave * 8192);
    for (int e = lane; e < 2048; e += 64) { const int rr = e >> 7, kk = e & 127; const int cr = row0 + rr;
        const float* cp = cr < NBATCH ? c_prompt_ + (size_t)cr * 1024 : c_sample_ + (size_t)(cr - NBATCH) * 1024; tab[e] = siluf_(cp[k0 + kk]); }
    asm volatile("s_waitcnt lgkmcnt(0)" ::: "memory");
    float acc[16];
#pragma unroll
    for (int r = 0; r < 16; ++r) acc[r] = 0.f;
    const float* wp = w_ada_ + (size_t)l * 1024 * 3072 + (size_t)k0 * 3072 + col;
#pragma unroll 2
    for (int kk = 0; kk < 128; kk += 4) {
        const float w0 = wp[(size_t)(kk + 0) * 3072], w1 = wp[(size_t)(kk + 1) * 3072], w2 = wp[(size_t)(kk + 2) * 3072], w3 = wp[(size_t)(kk + 3) * 3072];
#pragma unroll
        for (int r = 0; r < 16; ++r) { const f32x4 t = *(const LAS f32x4*)(tab + r * 128 + kk); acc[r] += (t[0] * w0 + t[1] * w1) + (t[2] * w2 + t[3] * w3); }
    }
    LAS float* red = (LAS float*)(lds + 65536);
#pragma unroll
    for (int r = 0; r < 16; ++r) red[(wave * 16 + r) * 64 + lane] = acc[r];
    __syncthreads();
    float* mod = (float*)(ws_ + WS_MOD);
    for (int e = tid; e < 1024; e += NTHREADS) { const int rr = e >> 6, cc = e & 63; float s = 0.f;
#pragma unroll
        for (int w = 0; w < 8; ++w) s += red[(w * 16 + rr) * 64 + cc];
        const int colg = cb * 64 + cc; mod[((size_t)l * NCOND + row0 + rr) * 3072 + colg] = s + b_ada_[l * 3072 + colg]; }
    __syncthreads();
}

__device__ __forceinline__ void p0_phase(const PT& a, LAS unsigned char* lds, int tid, int bid, int G) {
    const float* w_in_ = a.w_in(); const float* w_gm_out_ = a.w_gm_out(); const float* w_att_out_ = a.w_att_out(); const float* w_o_ = a.w_o(); unsigned char* ws_ = a.ws();
    const int wave = tid >> 6, lane = tid & 63;
    for (int it = bid; it < 288; it += G) p0_mod_item(a, lds, it, tid);
    { f32x2* rt = (f32x2*)(ws_ + WS_ROPE);
      for (int e = bid * NTHREADS + tid; e < 2056 * 32; e += G * NTHREADS) { const int pi = e >> 5, i = e & 31; const int pos = pi < SEQ ? pi : PAST + (pi - SEQ);
          const float ang = (float)pos * INV_FREQ[i]; const double rv = (double)ang * 0.15915494309189535; const float f = (float)(rv - rint(rv));
          f32x2 cs; cs.x = __builtin_amdgcn_cosf(f); cs.y = __builtin_amdgcn_sinf(f); rt[e] = cs; } }
    { const float* gm_ws_ = a.gm_ws(); bf16* wmb = (bf16*)(ws_ + WS_WMB);
      for (int e = bid * NTHREADS + tid; e < 2 * 8 * 16384; e += G * NTHREADS) { const int sidx = e & 127, tt = (e >> 7) & 127; wmb[e] = sidx <= tt ? (bf16)f2bf(gm_ws_[e]) : (bf16)0; } }
    LAS float* scr = (LAS float*)(lds + wave * 16384);
    const int gw = bid * 8 + wave, NGW = G * 8;
    constexpr int I_IN = 16 * 320, I_GM = 16 * 32, I_ATT = 8 * 32, I_O = 16 * 32, I_L = I_IN + I_GM + I_ATT + I_O;
    for (int it = gw; it < 2 * I_L; it += NGW) {
        const int l = it / I_L; int r = it % I_L;
        if (r < I_IN) { p0_transpose_item(w_in_ + (size_t)l * 1024 * NPROJ, 1024, NPROJ, (bf16*)(ws_ + WS_WTIN) + (size_t)l * NPROJ * 1024, scr, r, lane); continue; } r -= I_IN;
        if (r < I_GM) { p0_transpose_item(w_gm_out_ + (size_t)l * 1024 * 1024, 1024, 1024, (bf16*)(ws_ + WS_WTGM) + (size_t)l * 1024 * 1024, scr, r, lane); continue; } r -= I_GM;
        if (r < I_ATT) { p0_transpose_item(w_att_out_ + (size_t)l * 512 * 1024, 512, 1024, (bf16*)(ws_ + WS_WTATT) + (size_t)l * 1024 * 512, scr, r, lane); continue; } r -= I_ATT;
        p0_transpose_item(w_o_ + (size_t)l * 1024 * 1024, 1024, 1024, (bf16*)(ws_ + WS_WTO) + (size_t)l * 1024 * 1024, scr, r, lane);
    }
}

__device__ __forceinline__ void norm_phase(const PT& a, int l  , const float* xbuf  , int tid, int bid, int G) {
    const float* x_prompt_ = a.x_prompt(); const float* x_sample_ = a.x_sample(); const float* norm_g_ = a.norm_g(); const float* final_g_ = a.final_g(); float* out_ = a.out(); unsigned char* ws_ = a.ws();
    const int wave = tid >> 6, lane = tid & 63; const int gw = bid * 8 + wave, NGW = G * 8;
    const float* mod = (const float*)(ws_ + WS_MOD);
    bf16* H = (bf16*)(ws_ + WS_H);
    for (int m = gw; m < MROWS; m += NGW) {
        const float* xr = xbuf ? xbuf + (size_t)m * 1024 : (m < MP ? x_prompt_ + (size_t)m * 1024 : x_sample_ + (size_t)(m - MP) * 1024);
        f32x4 v[4]; float ss = 0.f;
#pragma unroll
        for (int j = 0; j < 4; ++j) { v[j] = *(const f32x4*)(xr + 4 * lane + 256 * j); ss += (v[j][0] * v[j][0] + v[j][1] * v[j][1]) + (v[j][2] * v[j][2] + v[j][3] * v[j][3]); }
        const float rstd = 1.0f / sqrtf(wave_sum(ss) * (1.0f / 1024.0f) + 1e-6f);
        if (l < 2) {
            const float* mr = mod + ((size_t)l * NCOND + cond_row(m)) * 3072;
#pragma unroll
            for (int j = 0; j < 4; ++j) { const int c = 4 * lane + 256 * j; const f32x4 g = *(const f32x4*)(norm_g_ + l * 1024 + c), sh = *(const f32x4*)(mr + c), sc = *(const f32x4*)(mr + 1024 + c);
                const f32x4 h = (v[j] * rstd) * g * (sc + 1.0f) + sh; u32x2 w; w.x = pk2(h[0], h[1]); w.y = pk2(h[2], h[3]); *(u32x2*)(H + (size_t)m * 1024 + c) = w; }
        } else {
#pragma unroll
            for (int j = 0; j < 4; ++j) { const int c = 4 * lane + 256 * j; const f32x4 g = *(const f32x4*)(final_g_ + c); *(f32x4*)(out_ + O_Y + (size_t)m * 1024 + c) = (v[j] * rstd) * g; }
        }
    }
}

__device__ __forceinline__ float* kv_out_ptr(float* out_, int l, int m, int g, int kvsel) {
    if (m >= MP) { const int r = m - MP; const size_t off = (g == 0 ? O_KVS0 : g == 1 ? O_KVS1 : O_KVS2); return out_ + off + (((size_t)l * MS + r) * 2 + kvsel) * 512; }
    const int b = m >> 11, t = m & 2047; const int nk = g == 0 ? 128 : g == 1 ? 512 : 2048; const int i = t - (SEQ - nk); if (i < 0) return nullptr;
    const size_t off = (g == 0 ? O_KVP0 : g == 1 ? O_KVP1 : O_KVP2); return out_ + off + ((((size_t)l * NBATCH + b) * nk + i) * 2 + kvsel) * 512;
}
__device__ __forceinline__ void p2a_phase(const PT& a, int l, int tid, int bid, int G) {
    const float* gm_ln_g_ = a.gm_ln_g(); const float* gm_ln_b_ = a.gm_ln_b(); float* out_ = a.out(); unsigned char* ws_ = a.ws();
    const int wave = tid >> 6, lane = tid & 63; const int gw = bid * 8 + wave, NGW = G * 8;
    bf16* P = (bf16*)(ws_ + WS_PROJ);
    const f32x2* rt = (const f32x2*)(ws_ + WS_ROPE);
    for (int m = gw; m < MROWS; m += NGW) {
        bf16* pr = P + (size_t)m * NPROJ;
        { const int pi = m < MP ? (m & 2047) : SEQ + ((m - MP) & 7); const f32x2 cs = rt[pi * 32 + (lane & 31)];
          for (int hh = 0; hh < 24; ++hh) { const int head = 2 * hh + (lane >> 5);
              bf16* hp = pr + C_Q + head * 64 + (lane & 31); const float x1 = bf2f(hp[0]), x2 = bf2f(hp[32]);
              const float o1 = x1 * cs.x - x2 * cs.y, o2 = x2 * cs.x + x1 * cs.y; hp[0] = (bf16)f2bf(o1); hp[32] = (bf16)f2bf(o2);
              if (head >= 24) { const int gh = head - 24, g = gh >> 3, h = gh & 7; float* ko = kv_out_ptr(out_, l, m, g, 0); if (ko) { ko[h * 64 + (lane & 31)] = o1; ko[h * 64 + 32 + (lane & 31)] = o2; } } } }
#pragma unroll
        for (int g = 0; g < 3; ++g) { float* vo = kv_out_ptr(out_, l, m, g, 1); if (vo) { const u32x4 w = *(const u32x4*)(pr + C_VAL + g * 512 + 8 * lane);
              *(f32x4*)(vo + 8 * lane) = (f32x4){bflo(w.x), bfhi(w.x), bflo(w.y), bfhi(w.y)}; *(f32x4*)(vo + 8 * lane + 4) = (f32x4){bflo(w.z), bfhi(w.z), bflo(w.w), bfhi(w.w)}; } }
    }
}

typedef short bf16x8_t __attribute__((ext_vector_type(8)));
typedef float f32x16 __attribute__((ext_vector_type(16)));
typedef short s16x4_t __attribute__((ext_vector_type(4)));
__device__ __forceinline__ s16x4_t vtr(LAS const unsigned char* p) { return __builtin_bit_cast(s16x4_t, __builtin_amdgcn_ds_read_tr16_b64_v4i16((LAS s16x4_t*)p)); }
__device__ __forceinline__ void spatial_item(const PT& a, int l, int ci, LAS unsigned char* lds, int tid) {
    unsigned char* ws_ = a.ws(); const float* lng_ = a.gm_ln_g() + l * 1024; const float* lnb_ = a.gm_ln_b() + l * 1024; const float* bs_ = a.gm_bs() + (size_t)l * 1024; float* out_ = a.out();
    const int wave = __builtin_amdgcn_readfirstlane(tid >> 6), lane = tid & 63;
    const int m0 = ci < 256 ? ci * 128 : MP + (ci - 256) * 8, nrows = ci < 256 ? 128 : 8;
    const bf16* P = (const bf16*)(ws_ + WS_PROJ); bf16* YA = (bf16*)(ws_ + WS_YA);
    LAS f32x2* stat = (LAS f32x2*)(lds + 131072);
    { const int nper = nrows >> 3;
      for (int rr = 0; rr < nper; ++rr) { const int row = wave * nper + rr; const bf16* pr = P + (size_t)(m0 + row) * NPROJ + C_V;
          float gv[16]; float sm = 0.f;
#pragma unroll
          for (int j = 0; j < 2; ++j) { const u32x4 w = *(const u32x4*)(pr + 8 * lane + 512 * j);
              gv[8 * j + 0] = geluf_(bflo(w.x)); gv[8 * j + 1] = geluf_(bfhi(w.x)); gv[8 * j + 2] = geluf_(bflo(w.y)); gv[8 * j + 3] = geluf_(bfhi(w.y));
              gv[8 * j + 4] = geluf_(bflo(w.z)); gv[8 * j + 5] = geluf_(bfhi(w.z)); gv[8 * j + 6] = geluf_(bflo(w.w)); gv[8 * j + 7] = geluf_(bfhi(w.w)); }
#pragma unroll
          for (int i = 0; i < 16; ++i) sm += gv[i];
          const float mu = wave_sum(sm) * (1.0f / 1024.0f); float q = 0.f;
#pragma unroll
          for (int i = 0; i < 16; ++i) { const float dlt = gv[i] - mu; q += dlt * dlt; }
          const float rstd = 1.0f / sqrtf(wave_sum(q) * (1.0f / 1024.0f) + 1e-5f);
          if (lane == 0) stat[row] = (f32x2){mu, rstd};
          if (nrows == 8) {
#pragma unroll
              for (int j = 0; j < 2; ++j) { const int c = 8 * lane + 512 * j; float o[8];
#pragma unroll
                  for (int i = 0; i < 8; ++i) o[i] = (gv[8 * j + i] - mu) * rstd * lng_[c + i] + lnb_[c + i];
                  float* go = out_ + O_GMV + ((size_t)l * MS + (m0 - MP + row)) * 1024 + c; *(f32x4*)go = (f32x4){o[0], o[1], o[2], o[3]}; *(f32x4*)(go + 4) = (f32x4){o[4], o[5], o[6], o[7]}; } }
      } }
    __syncthreads();
    { const int g = wave, t32 = lane & 31, hi = lane >> 5; LAS unsigned char* img = lds + wave * 16384;
      const bf16* wmb = (const bf16*)(ws_ + WS_WMB) + ((size_t)l * 8 + g) * 16384;
      for (int hf = 0; hf < 2; ++hf) { const int col0 = g * 128 + hf * 64, c = lane & 7;
          float lg[8], lb[8];
#pragma unroll
          for (int i = 0; i < 8; ++i) { lg[i] = lng_[col0 + 8 * c + i]; lb[i] = lnb_[col0 + 8 * c + i]; }
#pragma unroll 4
          for (int i = 0; i < 16; ++i) { const int row = 8 * i + (lane >> 3); u32x4 w = (u32x4){0u, 0u, 0u, 0u};
              if (row < nrows) { const u32x4 x = *(const u32x4*)(P + (size_t)(m0 + row) * NPROJ + C_V + col0 + 8 * c); const f32x2 st = stat[row];
                  w.x = pk2((geluf_(bflo(x.x)) - st.x) * st.y * lg[0] + lb[0], (geluf_(bfhi(x.x)) - st.x) * st.y * lg[1] + lb[1]);
                  w.y = pk2((geluf_(bflo(x.y)) - st.x) * st.y * lg[2] + lb[2], (geluf_(bfhi(x.y)) - st.x) * st.y * lg[3] + lb[3]);
                  w.z = pk2((geluf_(bflo(x.z)) - st.x) * st.y * lg[4] + lb[4], (geluf_(bfhi(x.z)) - st.x) * st.y * lg[5] + lb[5]);
                  w.w = pk2((geluf_(bflo(x.w)) - st.x) * st.y * lg[6] + lb[6], (geluf_(bfhi(x.w)) - st.x) * st.y * lg[7] + lb[7]); }
              *(LAS u32x4*)(img + (c >> 2) * 8192 + row * 64 + (c & 3) * 16) = w; }
          const int gidx = lane >> 4, qp = (lane & 15) >> 2, pp = lane & 3;
          LAS const unsigned char* rp = img + (8 * (gidx >> 1) + qp) * 64 + (16 * (gidx & 1) + 4 * pp) * 2;
          const int ntt = nrows == 128 ? 4 : 1;
#pragma unroll
          for (int tt = 0; tt < 4; ++tt) { if (tt < ntt) {
              bf16x8_t bfr[8];
#pragma unroll
              for (int ks = 0; ks < 2 * tt + 2; ++ks) bfr[ks] = *(const bf16x8_t*)(wmb + (size_t)(32 * tt + t32) * 128 + 16 * ks + 8 * hi);
              const int t = 32 * tt + t32; const float bsv = bs_[g * 128 + (t < 128 ? t : 0)];
#pragma unroll
              for (int dhh = 0; dhh < 2; ++dhh) { f32x16 acc;
#pragma unroll
                  for (int j = 0; j < 16; ++j) acc[j] = 0.f;
#pragma unroll
                  for (int ks = 0; ks < 2 * tt + 2; ++ks) { const s16x4_t lo = vtr(rp + dhh * 8192 + ks * 1024), hi4 = vtr(rp + dhh * 8192 + ks * 1024 + 256);
                      const bf16x8_t af = (bf16x8_t){lo[0], lo[1], lo[2], lo[3], hi4[0], hi4[1], hi4[2], hi4[3]};
                      acc = __builtin_amdgcn_mfma_f32_32x32x16_bf16(af, bfr[ks], acc, 0, 0, 0); }
                  if (t < nrows) { const size_t m = (size_t)(m0 + t);
#pragma unroll
                      for (int j4 = 0; j4 < 4; ++j4) { const int dcol = col0 + dhh * 32 + 8 * j4 + 4 * hi;
                          const u32x2 uw = *(const u32x2*)(P + m * NPROJ + C_U + dcol), zw = *(const u32x2*)(P + m * NPROJ + C_ZA + dcol);
                          u32x2 o; o.x = pk2(geluf_(bflo(uw.x)) * (acc[4 * j4 + 0] + bsv) * siluf_(bflo(zw.x)), geluf_(bfhi(uw.x)) * (acc[4 * j4 + 1] + bsv) * siluf_(bfhi(zw.x)));
                          o.y = pk2(geluf_(bflo(uw.y)) * (acc[4 * j4 + 2] + bsv) * siluf_(bflo(zw.y)), geluf_(bfhi(uw.y)) * (acc[4 * j4 + 3] + bsv) * siluf_(bfhi(zw.y)));
                          *(u32x2*)(YA + m * 1024 + dcol) = o; } }
              } } }
      } }
    __syncthreads();
}
__device__ __forceinline__ void spatial_phase(const PT& a, int l, LAS unsigned char* lds, int tid, int bid, int G) {
    for (int it = bid; it < 256 + DBATCH; it += G) spatial_item(a, l, it, lds, tid);
}

__device__ __forceinline__ int crow(int j, int hi) { return (j & 3) + 8 * (j >> 2) + 4 * hi; }
__device__ __forceinline__ unsigned cvtpk(float lo, float hi) { unsigned r; asm volatile("v_cvt_pk_bf16_f32 %0, %1, %2" : "=v"(r) : "v"(lo), "v"(hi)); return r; }
constexpr float ATT_SCALE2 = 0.125f * 1.4426950408889634f;

template <int NT> __device__ __forceinline__ void attn_unit(const bf16* Qb, const bf16* Kb, const bf16* Vb, int pitch, int dil, int r, int qt, bf16* Og, float* Lg, LAS unsigned char* vst, int lane) {
    const int q32 = lane & 31, hi = lane >> 5;
    const size_t qtok = (size_t)((32 * qt + q32) * dil + r);
    bf16x8_t qf[4];
#pragma unroll
    for (int ks = 0; ks < 4; ++ks) qf[ks] = *(const bf16x8_t*)(Qb + qtok * pitch + 16 * ks + 8 * hi);
    f32x16 st[NT];
#pragma unroll
    for (int ti = 0; ti < NT; ++ti) { const int kt = qt - (NT - 1) + ti;
        const bf16* kp = Kb + (size_t)((32 * kt + q32) * dil + r) * pitch + 8 * hi;
        const bf16x8_t k0 = *(const bf16x8_t*)kp, k1 = *(const bf16x8_t*)(kp + 16), k2 = *(const bf16x8_t*)(kp + 32), k3 = *(const bf16x8_t*)(kp + 48);
        f32x16 acc;
#pragma unroll
        for (int j = 0; j < 16; ++j) acc[j] = 0.f;
        acc = __builtin_amdgcn_mfma_f32_32x32x16_bf16(k0, qf[0], acc, 0, 0, 0); acc = __builtin_amdgcn_mfma_f32_32x32x16_bf16(k1, qf[1], acc, 0, 0, 0);
        acc = __builtin_amdgcn_mfma_f32_32x32x16_bf16(k2, qf[2], acc, 0, 0, 0); acc = __builtin_amdgcn_mfma_f32_32x32x16_bf16(k3, qf[3], acc, 0, 0, 0);
#pragma unroll
        for (int j = 0; j < 16; ++j) { const int cr = crow(j, hi); bool valid = true;
            if (NT == 5 && ti == 0) valid = cr >= q32;
            if (ti == NT - 1) valid = valid && (cr <= q32);
            st[ti][j] = valid ? acc[j] * ATT_SCALE2 : -1e30f; }
    }
    float mx = -1e30f;
#pragma unroll
    for (int ti = 0; ti < NT; ++ti)
#pragma unroll
        for (int j = 0; j < 16; ++j) mx = fmaxf(mx, st[ti][j]);
    mx = fmaxf(mx, __shfl_xor(mx, 32));
    float lsum = 0.f;
#pragma unroll
    for (int ti = 0; ti < NT; ++ti)
#pragma unroll
        for (int j = 0; j < 16; ++j) { st[ti][j] = __builtin_amdgcn_exp2f(st[ti][j] - mx); lsum += st[ti][j]; }
    lsum += __shfl_xor(lsum, 32);
    f32x16 o[2];
#pragma unroll
    for (int j = 0; j < 16; ++j) { o[0][j] = 0.f; o[1][j] = 0.f; }
#pragma unroll
    for (int ti = 0; ti < NT; ++ti) { const int kt = qt - (NT - 1) + ti; LAS unsigned char* img = vst + (ti & 1) * 4096;
#pragma unroll
        for (int jj = 0; jj < 4; ++jj) { const int key = 8 * jj + (lane >> 3), c = lane & 7;
            const u32x4 vv = *(const u32x4*)(Vb + (size_t)((32 * kt + key) * dil + r) * pitch + 8 * c);
            *(LAS u32x4*)(img + (c >> 2) * 2048 + key * 64 + (c & 3) * 16) = vv; }
#pragma unroll
        for (int ks2 = 0; ks2 < 2; ++ks2) {
            u32x4 pw; pw.x = cvtpk(st[ti][8 * ks2 + 0], st[ti][8 * ks2 + 1]); pw.y = cvtpk(st[ti][8 * ks2 + 2], st[ti][8 * ks2 + 3]); pw.z = cvtpk(st[ti][8 * ks2 + 4], st[ti][8 * ks2 + 5]); pw.w = cvtpk(st[ti][8 * ks2 + 6], st[ti][8 * ks2 + 7]);
            const bf16x8_t pf = __builtin_bit_cast(bf16x8_t, pw);
            const int gidx = lane >> 4, qp = (lane & 15) >> 2, pp = lane & 3;
            LAS const unsigned char* rp = img + (16 * ks2 + 4 * (gidx >> 1) + qp) * 64 + (16 * (gidx & 1) + 4 * pp) * 2;
#pragma unroll
            for (int dh = 0; dh < 2; ++dh) { const s16x4_t lo = vtr(rp + dh * 2048), hi4 = vtr(rp + dh * 2048 + 8 * 64);
                const bf16x8_t vf = (bf16x8_t){lo[0], lo[1], lo[2], lo[3], hi4[0], hi4[1], hi4[2], hi4[3]};
                o[dh] = __builtin_amdgcn_mfma_f32_32x32x16_bf16(vf, pf, o[dh], 0, 0, 0); }
        }
    }
    const float inv = 1.0f / lsum; bf16* op = Og + qtok * 512;
#pragma unroll
    for (int dh = 0; dh < 2; ++dh)
#pragma unroll
        for (int j4 = 0; j4 < 4; ++j4) { u32x2 w; w.x = cvtpk(o[dh][4 * j4 + 0] * inv, o[dh][4 * j4 + 1] * inv); w.y = cvtpk(o[dh][4 * j4 + 2] * inv, o[dh][4 * j4 + 3] * inv);
            *(u32x2*)(op + 32 * dh + 8 * j4 + 4 * hi) = w; }
    if (hi == 0) Lg[qtok * 8] = (mx + __builtin_amdgcn_logf(lsum)) * 0.6931471805599453f;
}

__device__ __forceinline__ void attn_prompt_item(const PT& a, int item, LAS unsigned char* lds, int tid) {
    unsigned char* ws_ = a.ws();
    const int wave = __builtin_amdgcn_readfirstlane(tid >> 6), lane = tid & 63; const int c = item & 3, h = (item >> 2) & 7, b = item >> 5;
    const bf16* P = (const bf16*)(ws_ + WS_PROJ) + (size_t)b * SEQ * NPROJ; bf16* OG = (bf16*)(ws_ + WS_OG) + (size_t)b * SEQ * 512 + h * 64; float* LSE = (float*)(ws_ + WS_LSE) + (size_t)b * SEQ * 8 + h;
    LAS unsigned char* vst = lds + wave * 8192;
    for (int i = 0; i < 6; ++i) { const int u = wave + 8 * i, g = u >> 4, j = u & 15;
        int dil, r, qt; if (g == 0) { dil = 1; r = 0; qt = 16 * c + j; } else if (g == 1) { dil = 4; r = j >> 2; qt = 4 * c + (j & 3); } else { dil = 16; r = j; qt = c; }
        const bf16* Qb = P + C_Q + g * 512 + h * 64; const bf16* Kb = P + C_K + g * 512 + h * 64; const bf16* Vb = P + C_VAL + g * 512 + h * 64;
        bf16* Og = OG + (size_t)g * OG_STRIDE; float* Lg = LSE + (size_t)g * LSE_STRIDE;
        const int nt = qt >= 4 ? 5 : qt + 1;
        switch (nt) {
            case 1: attn_unit<1>(Qb, Kb, Vb, NPROJ, dil, r, qt, Og, Lg, vst, lane); break;
            case 2: attn_unit<2>(Qb, Kb, Vb, NPROJ, dil, r, qt, Og, Lg, vst, lane); break;
            case 3: attn_unit<3>(Qb, Kb, Vb, NPROJ, dil, r, qt, Og, Lg, vst, lane); break;
            case 4: attn_unit<4>(Qb, Kb, Vb, NPROJ, dil, r, qt, Og, Lg, vst, lane); break;
            default: attn_unit<5>(Qb, Kb, Vb, NPROJ, dil, r, qt, Og, Lg, vst, lane); break;
        }
    }
    __syncthreads();
    { const size_t t = (size_t)(512 * c + tid); const float l0 = LSE[t * 8], l1 = LSE[LSE_STRIDE + t * 8], l2 = LSE[2 * LSE_STRIDE + t * 8];
      const float mx = fmaxf(l0, fmaxf(l1, l2)); float w0 = __expf(l0 - mx), w1 = __expf(l1 - mx), w2 = __expf(l2 - mx); const float inv = 1.0f / (w0 + w1 + w2); w0 *= inv; w1 *= inv; w2 *= inv;
      const bf16* zp = P + t * NPROJ + C_ZB + h * 64; bf16* yp = (bf16*)(ws_ + WS_YB) + ((size_t)b * SEQ + t) * 512 + h * 64;
#pragma unroll 2
      for (int k8 = 0; k8 < 8; ++k8) {
          const u32x4 a0 = *(const u32x4*)(OG + t * 512 + 8 * k8), a1 = *(const u32x4*)(OG + OG_STRIDE + t * 512 + 8 * k8), a2 = *(const u32x4*)(OG + 2 * OG_STRIDE + t * 512 + 8 * k8), zb = *(const u32x4*)(zp + 8 * k8);
          u32x4 o;
          o.x = pk2((w0 * bflo(a0.x) + w1 * bflo(a1.x) + w2 * bflo(a2.x)) * siluf_(bflo(zb.x)), (w0 * bfhi(a0.x) + w1 * bfhi(a1.x) + w2 * bfhi(a2.x)) * siluf_(bfhi(zb.x)));
          o.y = pk2((w0 * bflo(a0.y) + w1 * bflo(a1.y) + w2 * bflo(a2.y)) * siluf_(bflo(zb.y)), (w0 * bfhi(a0.y) + w1 * bfhi(a1.y) + w2 * bfhi(a2.y)) * siluf_(bfhi(zb.y)));
          o.z = pk2((w0 * bflo(a0.z) + w1 * bflo(a1.z) + w2 * bflo(a2.z)) * siluf_(bflo(zb.z)), (w0 * bfhi(a0.z) + w1 * bfhi(a1.z) + w2 * bfhi(a2.z)) * siluf_(bfhi(zb.z)));
          o.w = pk2((w0 * bflo(a0.w) + w1 * bflo(a1.w) + w2 * bflo(a2.w)) * siluf_(bflo(zb.w)), (w0 * bfhi(a0.w) + w1 * bfhi(a1.w) + w2 * bfhi(a2.w)) * siluf_(bfhi(zb.w)));
          *(u32x4*)(yp + 8 * k8) = o; }
    }
}

__device__ __forceinline__ void attn_sample_item(const PT& a, int l, int item, LAS unsigned char* lds, int tid) {
    unsigned char* ws_ = a.ws(); const float* cache0_ = a.cache0(); const float* cache1_ = a.cache1(); const float* cache2_ = a.cache2();
    const int wave = __builtin_amdgcn_readfirstlane(tid >> 6), lane = tid & 63; const int b = item >> 3, t = item & 7; const int h = lane >> 3, ds = (lane & 7) * 8;
    const bf16* P = (const bf16*)(ws_ + WS_PROJ); const size_t m = (size_t)MP + item;
    LAS float* PO = (LAS float*)(lds + 65536); LAS float* PM = (LAS float*)(lds + 65536 + 49152); LAS float* PL = PM + 192;
    for (int g = 0; g < 3; ++g) { const int dil = g == 0 ? 1 : g == 1 ? 4 : 16, nprev = 128 * dil;
        const float* cache = (g == 0 ? cache0_ : g == 1 ? cache1_ : cache2_) + ((size_t)l * DBATCH + b) * nprev * 1024;
        float q[8]; { const u32x4 w = *(const u32x4*)(P + m * NPROJ + C_Q + g * 512 + h * 64 + ds);
            q[0] = bflo(w.x) * ATT_SCALE2; q[1] = bfhi(w.x) * ATT_SCALE2; q[2] = bflo(w.y) * ATT_SCALE2; q[3] = bfhi(w.y) * ATT_SCALE2; q[4] = bflo(w.z) * ATT_SCALE2; q[5] = bfhi(w.z) * ATT_SCALE2; q[6] = bflo(w.w) * ATT_SCALE2; q[7] = bfhi(w.w) * ATT_SCALE2; }
        float o[8];
#pragma unroll
        for (int i = 0; i < 8; ++i) o[i] = 0.f;
        float mx = -1e30f, lsum = 0.f;
        const int j0 = wave == 0 ? 0 : 16 * wave + 1, j1 = 16 * wave + 16;
        for (int jb = j0; jb <= j1; jb += 8) {
            float kf[8][8], vf[8][8];
#pragma unroll
            for (int u = 0; u < 8; ++u) { const int j = jb + u <= j1 ? jb + u : j1; const int idx = nprev + t - dil * j;
                if (idx >= nprev) { const bf16* kp = P + ((size_t)MP + b * 8 + (idx - nprev)) * NPROJ + C_K + g * 512 + h * 64 + ds; const u32x4 kw = *(const u32x4*)kp, vw = *(const u32x4*)(kp + (C_VAL - C_K));
                    kf[u][0] = bflo(kw.x); kf[u][1] = bfhi(kw.x); kf[u][2] = bflo(kw.y); kf[u][3] = bfhi(kw.y); kf[u][4] = bflo(kw.z); kf[u][5] = bfhi(kw.z); kf[u][6] = bflo(kw.w); kf[u][7] = bfhi(kw.w);
                    vf[u][0] = bflo(vw.x); vf[u][1] = bfhi(vw.x); vf[u][2] = bflo(vw.y); vf[u][3] = bfhi(vw.y); vf[u][4] = bflo(vw.z); vf[u][5] = bfhi(vw.z); vf[u][6] = bflo(vw.w); vf[u][7] = bfhi(vw.w);
                } else { const float* kp = cache + (size_t)idx * 1024 + h * 64 + ds; const f32x4 k0 = *(const f32x4*)kp, k1 = *(const f32x4*)(kp + 4), v0 = *(const f32x4*)(kp + 512), v1 = *(const f32x4*)(kp + 516);
                    kf[u][0] = k0[0]; kf[u][1] = k0[1]; kf[u][2] = k0[2]; kf[u][3] = k0[3]; kf[u][4] = k1[0]; kf[u][5] = k1[1]; kf[u][6] = k1[2]; kf[u][7] = k1[3];
                    vf[u][0] = v0[0]; vf[u][1] = v0[1]; vf[u][2] = v0[2]; vf[u][3] = v0[3]; vf[u][4] = v1[0]; vf[u][5] = v1[1]; vf[u][6] = v1[2]; vf[u][7] = v1[3]; } }
#pragma unroll
            for (int u = 0; u < 8; ++u) { if (jb + u <= j1) {
                float s = 0.f;
#pragma unroll
                for (int i = 0; i < 8; ++i) s += q[i] * kf[u][i];
                s += __shfl_xor(s, 1); s += __shfl_xor(s, 2); s += __shfl_xor(s, 4);
                const float mn = fmaxf(mx, s), corr = __builtin_amdgcn_exp2f(mx - mn), p = __builtin_amdgcn_exp2f(s - mn); mx = mn; lsum = lsum * corr + p;
#pragma unroll
                for (int i = 0; i < 8; ++i) o[i] = o[i] * corr + p * vf[u][i]; } }
        }
        const int pi = g * 8 + wave;
        *(LAS f32x4*)(PO + pi * 512 + lane * 8) = (f32x4){o[0], o[1], o[2], o[3]}; *(LAS f32x4*)(PO + pi * 512 + lane * 8 + 4) = (f32x4){o[4], o[5], o[6], o[7]};
        if ((lane & 7) == 0) { PM[pi * 8 + h] = mx; PL[pi * 8 + h] = lsum; }
    }
    __syncthreads();
    { const int hh = tid >> 6; float M = -1e30f;
#pragma unroll
      for (int p = 0; p < 24; ++p) M = fmaxf(M, PM[p * 8 + hh]);
      float L = 0.f, acc = 0.f;
#pragma unroll
      for (int p = 0; p < 24; ++p) { const float w = __builtin_amdgcn_exp2f(PM[p * 8 + hh] - M); L += w * PL[p * 8 + hh]; acc += w * PO[p * 512 + tid]; }
      const float zb = bf2f(P[m * NPROJ + C_ZB + tid]);
      ((bf16*)(ws_ + WS_YB))[m * 512 + tid] = (bf16)f2bf(acc / L * siluf_(zb)); }
    __syncthreads();
}

__device__ __forceinline__ void attn_phase(const PT& a, int l, LAS unsigned char* lds, int tid, int bid, int G) {
    for (int it = bid; it < MS; it += G) attn_sample_item(a, l, it, lds, tid);
    for (int it = bid; it < NBATCH * 8 * 4; it += G) attn_prompt_item(a, it, lds, tid);
}


__global__ void __launch_bounds__(NTHREADS, 2) hybrid_step_fwd(Args ka) {
    extern __shared__ __attribute__((aligned(16))) unsigned char lds_raw[];
    LAS unsigned char* lds = (LAS unsigned char*)lds_raw;
    cg::grid_group grid = cg::this_grid();
    const int bid = blockIdx.x, G = gridDim.x;
    { LAS unsigned long long* pt = (LAS unsigned long long*)(lds + PTAB_OFF);
      if (threadIdx.x == 0) { pt[0] = (unsigned long long)ka.x_prompt; pt[1] = (unsigned long long)ka.x_sample; pt[2] = (unsigned long long)ka.cache0; pt[3] = (unsigned long long)ka.cache1; pt[4] = (unsigned long long)ka.cache2;
          pt[5] = (unsigned long long)ka.c_prompt; pt[6] = (unsigned long long)ka.c_sample; pt[7] = (unsigned long long)ka.w_ada; pt[8] = (unsigned long long)ka.b_ada; pt[9] = (unsigned long long)ka.norm_g;
          pt[10] = (unsigned long long)ka.w_in; pt[11] = (unsigned long long)ka.gm_ln_g; pt[12] = (unsigned long long)ka.gm_ln_b; pt[13] = (unsigned long long)ka.gm_ws; pt[14] = (unsigned long long)ka.gm_bs;
          pt[15] = (unsigned long long)ka.w_gm_out; pt[16] = (unsigned long long)ka.w_att_out; pt[17] = (unsigned long long)ka.w_o; pt[18] = (unsigned long long)ka.final_g; pt[19] = (unsigned long long)ka.out; pt[20] = (unsigned long long)ka.ws; }
      __syncthreads(); }
    PT a; a.t = (LAS const unsigned long long*)(lds + PTAB_OFF);
#define TID() ({ int t_ = threadIdx.x; asm volatile("" : "+v"(t_)); t_; })
#define WSP(T, off) ((T*)(a.ws() + (off)))

    p0_phase(a, lds, TID(), bid, G);
    grid.sync();
    norm_phase(a, 0, nullptr, TID(), bid, G);
    grid.sync();
    for (int l = 0; l < 2; ++l) {
        { pg8::Gemm g{WSP(bf16, WS_H), WSP(bf16, WS_WTIN) + (size_t)l * NPROJ * 1024, MROWS, NPROJ, 1024}; pg8::StaticOrder S; S.init(MROWS, NPROJ, G, bid);
          pg8::EpiStoreBf16 E{WSP(bf16, WS_PROJ), NPROJ}; pg8::gemm_phase<pg8::EpiStoreBf16, pg8::StaticOrder, true, true>(lds, g, S, E); }
        grid.sync();
        p2a_phase(a, l, TID(), bid, G);
        grid.sync();
        spatial_phase(a, l, lds, TID(), bid, G);
        attn_phase(a, l, lds, TID(), bid, G);
        grid.sync();
        { pg8::Gemm g{WSP(bf16, WS_YA), WSP(bf16, WS_WTGM) + (size_t)l * 1024 * 1024, MROWS, 1024, 1024}; pg8::StaticOrder S; S.init(MROWS, 1024, G, bid);
          pg8::EpiGate1 E{WSP(float, WS_T), WSP(bf16, WS_PROJ) + C_GA, NPROJ}; pg8::gemm_phase<pg8::EpiGate1, pg8::StaticOrder, true, true>(lds, g, S, E); }
        { pg8::Gemm g{WSP(bf16, WS_YB), WSP(bf16, WS_WTATT) + (size_t)l * 1024 * 512, MROWS, 1024, 512}; pg8::StaticOrder S; S.init(MROWS, 1024, G, bid);
          pg8::EpiGate2 E{WSP(float, WS_T), WSP(bf16, WS_PROJ) + C_GB, NPROJ, WSP(bf16, WS_MERGED)}; pg8::gemm_phase<pg8::EpiGate2, pg8::StaticOrder, true, true>(lds, g, S, E); }
        grid.sync();
        { pg8::Gemm g{WSP(bf16, WS_MERGED), WSP(bf16, WS_WTO) + (size_t)l * 1024 * 1024, MROWS, 1024, 1024}; pg8::StaticOrder S; S.init(MROWS, 1024, G, bid);
          float* XB = WSP(float, WS_X);
          pg8::EpiResid E{l == 0 ? a.x_prompt() : XB, l == 0 ? a.x_sample() : XB + (size_t)MP * 1024, WSP(float, WS_MOD) + (size_t)l * NCOND * 3072 + 2048, XB};
          pg8::gemm_phase<pg8::EpiResid, pg8::StaticOrder, true, true>(lds, g, S, E); }
        grid.sync();
        norm_phase(a, l + 1, WSP(float, WS_X), TID(), bid, G);
        if (l == 0) grid.sync();
    }
}

extern "C" void kernel_launch(void* const* d_in, const int* in_sizes, int n_in, void* d_out, int out_size, void* d_ws, size_t ws_size, hipStream_t stream) {
    static int grid = 0;
    if (grid == 0) {
        if (n_in != 19 || (size_t)out_size != O_TOTAL || ws_size < WS_END) { fprintf(stderr, "kernel_launch: unexpected sizes: n_in %d out %d (want %zu) ws %zu (want >= %zu)\n", n_in, out_size, (size_t)O_TOTAL, ws_size, (size_t)WS_END); grid = -1; return; }
        int dev = 0, cus = 0, per_cu = 0;
        hipGetDevice(&dev); hipDeviceGetAttribute(&cus, hipDeviceAttributeMultiprocessorCount, dev);
        if (hipFuncSetAttribute((const void*)hybrid_step_fwd, hipFuncAttributeMaxDynamicSharedMemorySize, LDS_BYTES) != hipSuccess) { fprintf(stderr, "kernel_launch: hipFuncSetAttribute failed\n"); grid = -1; return; }
        if (hipOccupancyMaxActiveBlocksPerMultiprocessor(&per_cu, (const void*)hybrid_step_fwd, NTHREADS, LDS_BYTES) != hipSuccess || per_cu < 1) { fprintf(stderr, "kernel_launch: occupancy query failed (%d)\n", per_cu); (void)hipGetLastError(); grid = -1; return; }
        grid = cus * per_cu;
        fprintf(stderr, "kernel_launch: %d CUs x %d blocks/CU -> grid %d\n", cus, per_cu, grid);
    }
    if (grid < 0) return;
    Args a{};
    a.x_prompt = (const float*)d_in[0]; a.x_sample = (const float*)d_in[1]; a.cache0 = (const float*)d_in[2]; a.cache1 = (const float*)d_in[3]; a.cache2 = (const float*)d_in[4];
    a.c_prompt = (const float*)d_in[5]; a.c_sample = (const float*)d_in[6]; a.w_ada = (const float*)d_in[7]; a.b_ada = (const float*)d_in[8]; a.norm_g = (const float*)d_in[9];
    a.w_in = (const float*)d_in[10]; a.gm_ln_g = (const float*)d_in[11]; a.gm_ln_b = (const float*)d_in[12]; a.gm_ws = (const float*)d_in[13]; a.gm_bs = (const float*)d_in[14];
    a.w_gm_out = (const float*)d_in[15]; a.w_att_out = (const float*)d_in[16]; a.w_o = (const float*)d_in[17]; a.final_g = (const float*)d_in[18];
    a.out = (float*)d_out; a.ws = (unsigned char*)d_ws;
    void* args[] = {&a};
    hipError_t e = hipLaunchCooperativeKernel((const void*)hybrid_step_fwd, dim3(grid), dim3(NTHREADS), args, LDS_BYTES, stream);
    if (e != hipSuccess) fprintf(stderr, "kernel_launch: cooperative launch failed: %s (grid %d)\n", hipGetErrorString(e), grid);
}
```

```cpp
#include <hip/hip_runtime.h>
#include <hip/hip_cooperative_groups.h>
#include <cstdio>
#include <cstdint>
#include <cmath>
namespace cg = cooperative_groups;

constexpr int D = 1024, SEQ = 2048, NBATCH = 16, MP = NBATCH * SEQ, DBATCH = 32, TDEC = 8, MS = DBATCH * TDEC, MROWS = MP + MS;
constexpr int NPROJ = 10240, NCOND = 48, PAST = 16384;
constexpr int C_U = 0, C_V = 1024, C_ZA = 2048, C_Q = 3072, C_K = 4608, C_VAL = 6144, C_ZB = 7680, C_GA = 8192, C_GB = 9216;
constexpr size_t O_Y = 0, O_KVP0 = (size_t)MROWS * 1024, O_KVP1 = O_KVP0 + 4194304, O_KVP2 = O_KVP1 + 16777216, O_KVS0 = O_KVP2 + 67108864,
                 O_KVS1 = O_KVS0 + 524288, O_KVS2 = O_KVS1 + 524288, O_GMV = O_KVS2 + 524288, O_TOTAL = O_GMV + 524288;

typedef unsigned short bf16;
typedef float f32x4 __attribute__((ext_vector_type(4)));
typedef float f32x2 __attribute__((ext_vector_type(2)));
typedef unsigned u32x4 __attribute__((ext_vector_type(4)));
typedef unsigned u32x2 __attribute__((ext_vector_type(2)));
#define LAS __attribute__((address_space(3)))

__device__ __forceinline__ float sigmoidf_(float z) { return __builtin_amdgcn_rcpf(1.0f + __builtin_amdgcn_exp2f(-1.4426950408889634f * z)); }
__device__ __forceinline__ float siluf_(float z) { return z * sigmoidf_(z); }
__device__ __forceinline__ float geluf_(float x) { return x * sigmoidf_(1.5957691216057308f * (x + 0.044715f * x * x * x)); }
__device__ __forceinline__ unsigned f2bf(float f) { unsigned u = __builtin_bit_cast(unsigned, f); return (u + 0x7fffu + ((u >> 16) & 1u)) >> 16; }
__device__ __forceinline__ unsigned pk2(float lo, float hi) { return f2bf(lo) | (f2bf(hi) << 16); }
__device__ __forceinline__ float bflo(unsigned w) { return __builtin_bit_cast(float, w << 16); }
__device__ __forceinline__ float bfhi(unsigned w) { return __builtin_bit_cast(float, w & 0xffff0000u); }
__device__ __forceinline__ float bf2f(bf16 b) { return __builtin_bit_cast(float, (unsigned)b << 16); }
__device__ __forceinline__ int cond_row(int m) { return m < MP ? (m >> 11) : NBATCH + ((m - MP) >> 3); }

__device__ __forceinline__ float* kv_out_ptr(float* out_, int l, int m, int g, int kvsel) {
    if (m >= MP) { const int r = m - MP; const size_t off = (g == 0 ? O_KVS0 : g == 1 ? O_KVS1 : O_KVS2); return out_ + off + (((size_t)l * MS + r) * 2 + kvsel) * 512; }
    const int b = m >> 11, t = m & 2047; const int nk = g == 0 ? 128 : g == 1 ? 512 : 2048; const int i = t - (SEQ - nk); if (i < 0) return nullptr;
    const size_t off = (g == 0 ? O_KVP0 : g == 1 ? O_KVP1 : O_KVP2); return out_ + off + ((((size_t)l * NBATCH + b) * nk + i) * 2 + kvsel) * 512;
}
constexpr size_t MiB = 1u << 20;
constexpr size_t WS_MOD = 1 * MiB, WS_ROPE = 3 * MiB, WS_WTIN = 4 * MiB, WS_WTGM = 44 * MiB, WS_WTATT = 48 * MiB, WS_WTO = 50 * MiB, WS_WMB = 55 * MiB,
                 WS_H = 56 * MiB, WS_YA = 122 * MiB, WS_YB = 188 * MiB, WS_OG = 222 * MiB, WS_LSE = 320 * MiB, WS_MERGED = 324 * MiB,
                 WS_T = 390 * MiB, WS_X = 520 * MiB,
                 WS_UZ = 650 * MiB, WS_GV = 715 * MiB, WS_Q = 780 * MiB, WS_K = 877 * MiB, WS_V = 974 * MiB, WS_ZB = 1071 * MiB, WS_SGA = 1104 * MiB, WS_SGB = 1169 * MiB, WS_END = 1234 * MiB;
__host__ __device__ __forceinline__ int proj_src_col32(int nb) {
    const int pn = nb >> 3, wb = nb & 7, bj = wb >> 2, q4 = wb & 3;
    if (pn < 8) return (bj ? C_ZA : C_U) + 128 * pn + 32 * q4;
    if (pn < 12) return C_V + 256 * (pn - 8) + 32 * wb;
    if (pn < 18) return C_Q + (4 * (pn - 12) + q4) * 64 + 32 * bj;
    if (pn < 24) return C_K + (4 * (pn - 18) + q4) * 64 + 32 * bj;
    if (pn < 30) return C_VAL + 256 * (pn - 24) + 32 * wb;
    if (pn < 32) return C_ZB + 256 * (pn - 30) + 32 * wb;
    if (pn < 36) return C_GA + 256 * (pn - 32) + 32 * wb;
    return C_GB + 256 * (pn - 36) + 32 * wb;
}

namespace pg8 {
#define PG8_LAS __attribute__((address_space(3)))
typedef unsigned short bf16_t;
typedef short bf16x8 __attribute__((ext_vector_type(8)));
typedef float f32x4 __attribute__((ext_vector_type(4)));
typedef unsigned u32x4 __attribute__((ext_vector_type(4)));
constexpr int BM = 256, BK = 64, HALF = 128, HTB = HALF * BK * 2  , STAGE_BYTES = 8 * HTB, NXCD = 8, WGM = 8;

__host__ __device__ __forceinline__ int lds_byte(int r, int c) { const int st = (r >> 4) * 2 + (c >> 5), rr = r & 15, cc = c & 31, ob = rr * 64 + cc * 2; return st * 1024 + (ob ^ (((ob >> 9) & 1) << 5)); }
__host__ __device__ __forceinline__ void stage_rc(int b, int& R, int& C) { const int st = b / 1024, sb = b % 1024, swz = sb ^ (((sb >> 9) & 1) << 5); R = (st >> 1) * 16 + swz / 64; C = (st & 1) * 32 + (swz % 64) / 2; }
__host__ __device__ __forceinline__ int perm32(int rho) { const int n = rho >> 4, i = rho & 15; return 8 * (i >> 2) + 4 * n + (i & 3); }

struct Unit { int pm, pn; };
struct Gemm { const bf16_t* A; const bf16_t* Bt; int M, N, K; };

struct StaticOrder {
    int nM, nN, nwg, G, c;
    __host__ __device__ void init(int M, int N, int G_, int c_) { nM = M / BM; nN = N / BM; nwg = nM * nN; G = G_; c = c_; }
    __host__ __device__ bool next(int i, Unit& u) const {
        const long L = (long)i * G + c; if (L >= nwg) return false;
        int wgid = (int)L; { const int q = nwg / NXCD, r = nwg % NXCD, xcd = wgid % NXCD, off = wgid / NXCD; wgid = (xcd < r ? xcd * (q + 1) : r * (q + 1) + (xcd - r) * q) + off; }
        const int nig = WGM * nN, gid = wgid / nig, fm = gid * WGM, gsz = (nM - fm) < WGM ? (nM - fm) : WGM;
        u.pm = fm + ((wgid % nig) % gsz); u.pn = (wgid % nig) / gsz; return true;
    }
    __device__ __forceinline__ void a_ready(const Unit&) const {}
    __device__ __forceinline__ void done(const Unit&) const {}
};

__device__ __forceinline__ unsigned cvt_pk_bf16(float lo, float hi) { unsigned r; asm volatile("v_cvt_pk_bf16_f32 %0, %1, %2" : "=v"(r) : "v"(lo), "v"(hi)); return r; }
typedef float f32x2 __attribute__((ext_vector_type(2)));
__device__ __forceinline__ u32x4 pack8(const f32x4 a, const f32x4 b) { u32x4 w; w.x = cvt_pk_bf16(a[0], a[1]); w.y = cvt_pk_bf16(a[2], a[3]); w.z = cvt_pk_bf16(b[0], b[1]); w.w = cvt_pk_bf16(b[2], b[3]); return w; }
struct EpiProj {
    static constexpr bool PERM = true, AFTER_DRAIN = false;
    unsigned char* ws; float* out; int l;
    __device__ __forceinline__ void operator()(const f32x4 (&acc)[2][2][4][2], const Unit& u, int wr, int wc, int fr, int fq) const {
        const int pn = u.pn, row0 = u.pm * BM + wr * 64 + fr;
        if (pn < 8) {
            bf16_t* O = (bf16_t*)(ws + ::WS_UZ) + 128 * pn + 32 * wc + 8 * fq;
#pragma unroll
            for (int ai = 0; ai < 2; ++ai)
#pragma unroll
                for (int m = 0; m < 4; ++m) { f32x4 r0, r1;
#pragma unroll
                    for (int j = 0; j < 4; ++j) { r0[j] = ::geluf_(acc[ai][0][m][0][j]) * ::siluf_(acc[ai][1][m][0][j]); r1[j] = ::geluf_(acc[ai][0][m][1][j]) * ::siluf_(acc[ai][1][m][1][j]); }
                    *(u32x4*)(O + (size_t)(row0 + ai * HALF + m * 16) * 1024) = pack8(r0, r1); }
        } else if (pn < 12 || pn >= 30) {
            const int kind = pn < 12 ? 0 : pn < 32 ? 1 : 2;
            bf16_t* O; int ld;
            if (pn < 12) { O = (bf16_t*)(ws + ::WS_GV) + 256 * (pn - 8); ld = 1024; } else if (pn < 32) { O = (bf16_t*)(ws + ::WS_ZB) + 256 * (pn - 30); ld = 512; }
            else if (pn < 36) { O = (bf16_t*)(ws + ::WS_SGA) + 256 * (pn - 32); ld = 1024; } else { O = (bf16_t*)(ws + ::WS_SGB) + 256 * (pn - 36); ld = 1024; }
            O += 32 * wc + 8 * fq;
#pragma unroll
            for (int ai = 0; ai < 2; ++ai)
#pragma unroll
                for (int m = 0; m < 4; ++m)
#pragma unroll
                    for (int bj = 0; bj < 2; ++bj) { f32x4 r0, r1;
#pragma unroll
                        for (int j = 0; j < 4; ++j) { const float x0 = acc[ai][bj][m][0][j], x1 = acc[ai][bj][m][1][j];
                            r0[j] = kind == 0 ? ::geluf_(x0) : kind == 1 ? ::siluf_(x0) : ::sigmoidf_(x0); r1[j] = kind == 0 ? ::geluf_(x1) : kind == 1 ? ::siluf_(x1) : ::sigmoidf_(x1); }
                        *(u32x4*)(O + (size_t)(row0 + ai * HALF + m * 16) * ld + bj * HALF) = pack8(r0, r1); }
        } else if (pn < 24) {
            const bool isk = pn >= 18; const int head = 4 * (isk ? pn - 18 : pn - 12) + wc;
            bf16_t* O = (bf16_t*)(ws + (isk ? ::WS_K : ::WS_Q)) + head * 64 + 8 * fq;
            const f32x2* rt = (const f32x2*)(ws + ::WS_ROPE);
#pragma unroll
            for (int ai = 0; ai < 2; ++ai)
#pragma unroll
                for (int m = 0; m < 4; ++m) { const int row = row0 + ai * HALF + m * 16; const int pi = row < ::MP ? (row & 2047) : ::SEQ + ((row - ::MP) & 7);
                    const f32x4* cp = (const f32x4*)(rt + pi * 32 + 8 * fq); const f32x4 cs0 = cp[0], cs1 = cp[1], cs2 = cp[2], cs3 = cp[3];
                    const f32x4 xa = acc[ai][0][m][0], xb = acc[ai][0][m][1], ya = acc[ai][1][m][0], yb = acc[ai][1][m][1];
                    f32x4 o1a, o1b, o2a, o2b;
                    o1a[0] = xa[0] * cs0[0] - ya[0] * cs0[1]; o2a[0] = ya[0] * cs0[0] + xa[0] * cs0[1]; o1a[1] = xa[1] * cs0[2] - ya[1] * cs0[3]; o2a[1] = ya[1] * cs0[2] + xa[1] * cs0[3];
                    o1a[2] = xa[2] * cs1[0] - ya[2] * cs1[1]; o2a[2] = ya[2] * cs1[0] + xa[2] * cs1[1]; o1a[3] = xa[3] * cs1[2] - ya[3] * cs1[3]; o2a[3] = ya[3] * cs1[2] + xa[3] * cs1[3];
                    o1b[0] = xb[0] * cs2[0] - yb[0] * cs2[1]; o2b[0] = yb[0] * cs2[0] + xb[0] * cs2[1]; o1b[1] = xb[1] * cs2[2] - yb[1] * cs2[3]; o2b[1] = yb[1] * cs2[2] + xb[1] * cs2[3];
                    o1b[2] = xb[2] * cs3[0] - yb[2] * cs3[1]; o2b[2] = yb[2] * cs3[0] + xb[2] * cs3[1]; o1b[3] = xb[3] * cs3[2] - yb[3] * cs3[3]; o2b[3] = yb[3] * cs3[2] + xb[3] * cs3[3];
                    bf16_t* op = O + (size_t)row * 1536; *(u32x4*)op = pack8(o1a, o1b); *(u32x4*)(op + 32) = pack8(o2a, o2b);
                    if (isk) { float* ko = ::kv_out_ptr(out, l, row, head >> 3, 0); if (ko) { ko += (head & 7) * 64 + 8 * fq; *(f32x4*)ko = o1a; *(f32x4*)(ko + 4) = o1b; *(f32x4*)(ko + 32) = o2a; *(f32x4*)(ko + 36) = o2b; } } }
        } else {
            bf16_t* O = (bf16_t*)(ws + ::WS_V) + 256 * (pn - 24) + 32 * wc + 8 * fq;
#pragma unroll
            for (int ai = 0; ai < 2; ++ai)
#pragma unroll
                for (int m = 0; m < 4; ++m) { const int row = row0 + ai * HALF + m * 16;
#pragma unroll
                    for (int bj = 0; bj < 2; ++bj) { const int col = 256 * (pn - 24) + bj * HALF + 32 * wc + 8 * fq;
                        *(u32x4*)(O + (size_t)row * 1536 + bj * HALF) = pack8(acc[ai][bj][m][0], acc[ai][bj][m][1]);
                        float* vo = ::kv_out_ptr(out, l, row, col >> 9, 1); if (vo) { vo += col & 511; *(f32x4*)vo = acc[ai][bj][m][0]; *(f32x4*)(vo + 4) = acc[ai][bj][m][1]; } } }
        }
    }
};
struct EpiGate1 {
    static constexpr bool PERM = false, AFTER_DRAIN = false;
    float* Tq; const bf16_t* G; int ldg;
    __device__ __forceinline__ void operator()(const f32x4 (&acc)[2][2][4][2], const Unit& u, int wr, int wc, int fr, int fq) const {
        const int row0 = u.pm * BM + wr * 64 + fr, col0 = u.pn * BM + wc * 32 + 4 * fq;
#pragma unroll
        for (int ai = 0; ai < 2; ++ai)
#pragma unroll
            for (int m = 0; m < 4; ++m) { const size_t r = (size_t)(row0 + ai * HALF + m * 16);
#pragma unroll
                for (int bj = 0; bj < 2; ++bj)
#pragma unroll
                    for (int n = 0; n < 2; ++n) { const int c = col0 + bj * HALF + n * 16; const u32x2 gw = *(const u32x2*)(G + r * ldg + c);
                        f32x4 o; o[0] = ::bflo(gw.x) * acc[ai][bj][m][n][0]; o[1] = ::bfhi(gw.x) * acc[ai][bj][m][n][1];
                        o[2] = ::bflo(gw.y) * acc[ai][bj][m][n][2]; o[3] = ::bfhi(gw.y) * acc[ai][bj][m][n][3];
                        *(f32x4*)(Tq + r * 1024 + c) = o; } }
    }
};
struct EpiGate2 {
    static constexpr bool PERM = false, AFTER_DRAIN = false;
    const float* Tq; const bf16_t* G; int ldg; bf16_t* O;
    __device__ __forceinline__ void operator()(const f32x4 (&acc)[2][2][4][2], const Unit& u, int wr, int wc, int fr, int fq) const {
        const int row0 = u.pm * BM + wr * 64 + fr, col0 = u.pn * BM + wc * 32 + 4 * fq;
#pragma unroll
        for (int ai = 0; ai < 2; ++ai)
#pragma unroll
            for (int m = 0; m < 4; ++m) { const size_t r = (size_t)(row0 + ai * HALF + m * 16);
#pragma unroll
                for (int bj = 0; bj < 2; ++bj)
#pragma unroll
                    for (int n = 0; n < 2; ++n) { const int c = col0 + bj * HALF + n * 16; const u32x2 gw = *(const u32x2*)(G + r * ldg + c); const f32x4 t = *(const f32x4*)(Tq + r * 1024 + c);
                        const float o0 = t[0] + ::bflo(gw.x) * acc[ai][bj][m][n][0], o1 = t[1] + ::bfhi(gw.x) * acc[ai][bj][m][n][1];
                        const float o2 = t[2] + ::bflo(gw.y) * acc[ai][bj][m][n][2], o3 = t[3] + ::bfhi(gw.y) * acc[ai][bj][m][n][3];
                        u32x2 w; w.x = cvt_pk_bf16(o0, o1); w.y = cvt_pk_bf16(o2, o3); *(u32x2*)(O + r * 1024 + c) = w; } }
    }
};
struct EpiResid {
    static constexpr bool PERM = false, AFTER_DRAIN = false;
    const float* xp; const float* xs; const float* gate  ; float* xo;
    __device__ __forceinline__ void operator()(const f32x4 (&acc)[2][2][4][2], const Unit& u, int wr, int wc, int fr, int fq) const {
        const int row0 = u.pm * BM + wr * 64 + fr, col0 = u.pn * BM + wc * 32 + 4 * fq;
#pragma unroll
        for (int ai = 0; ai < 2; ++ai)
#pragma unroll
            for (int m = 0; m < 4; ++m) { const int r = row0 + ai * HALF + m * 16; const float* xr = r < ::MP ? xp + (size_t)r * 1024 : xs + (size_t)(r - ::MP) * 1024;
                const float* gr = gate + (size_t)::cond_row(r) * 3072;
#pragma unroll
                for (int bj = 0; bj < 2; ++bj)
#pragma unroll
                    for (int n = 0; n < 2; ++n) { const int c = col0 + bj * HALF + n * 16; const f32x4 xv = *(const f32x4*)(xr + c), gv = *(const f32x4*)(gr + c);
                        *(f32x4*)(xo + (size_t)r * 1024 + c) = xv + gv * acc[ai][bj][m][n]; } }
    }
};
template <class Epi, class Sched, bool ALIGN_EPI = false, bool SP2 = false>
__device__ __forceinline__ void gemm_phase(PG8_LAS unsigned char* lds, const Gemm g, const Sched& S, const Epi& E) {
    int tid_ = threadIdx.x; asm volatile("" : "+v"(tid_));
    const int tid = tid_, wid = __builtin_amdgcn_readfirstlane(tid >> 6), lane = tid & 63, wr = wid >> 2, wc = wid & 3, fr = lane & 15, fq = lane >> 4;
    const int K = g.K, nt = K / BK;
    unsigned voffA[2], voffB[2];
#pragma unroll
    for (int i = 0; i < 2; ++i) { int R, C; stage_rc(tid * 16 + i * 8192, R, C); const int Rb = Epi::PERM ? ((R & ~31) + perm32(R & 31)) : R;
        voffA[i] = (unsigned)(R * K + C) * 2u; voffB[i] = (unsigned)(Rb * K + C) * 2u; }
    const size_t kstep = (size_t)(BK * 2);
    const size_t hstep = (size_t)HALF * K * 2;
    const size_t tstep = 2 * hstep;
    const unsigned ldsw = (unsigned)wid * 1024u;
    const int aoff = lds_byte(wr * 64 + fr, fq * 8), boff = lds_byte(wc * 32 + fr, fq * 8);
#define PG8_SA(b, h) (((b) * 2 + (h)) * HTB)
#define PG8_SB(b, h) ((4 + (b) * 2 + (h)) * HTB)
#define PG8_STAGE(bufoff, gbase, voff) do { _Pragma("unroll") for (int _i = 0; _i < 2; ++_i) \
        __builtin_amdgcn_global_load_lds((const unsigned*)((const char*)(gbase) + (voff)[_i]), (PG8_LAS unsigned*)(lds + (bufoff) + ldsw + _i * 8192), 16, 0, 0); } while (0)
#define PG8_LDA(dst, b, h) do { _Pragma("unroll") for (int m = 0; m < 4; ++m) _Pragma("unroll") for (int k = 0; k < 2; ++k) dst[m][k] = *(const PG8_LAS bf16x8*)(lds + PG8_SA(b, h) + aoff + m * 2048 + k * 1024); } while (0)
#define PG8_LDB(dst, b, h) do { _Pragma("unroll") for (int n = 0; n < 2; ++n) _Pragma("unroll") for (int k = 0; k < 2; ++k) dst[n][k] = *(const PG8_LAS bf16x8*)(lds + PG8_SB(b, h) + boff + n * 2048 + k * 1024); } while (0)
#define PG8_MMA(ai, bj, At, Bt) do { __builtin_amdgcn_s_setprio(1); _Pragma("unroll") for (int m = 0; m < 4; ++m) _Pragma("unroll") for (int n = 0; n < 2; ++n) _Pragma("unroll") for (int k = 0; k < 2; ++k) \
        acc[ai][bj][m][n] = __builtin_amdgcn_mfma_f32_16x16x32_bf16(Bt[n][k], At[m][k], acc[ai][bj][m][n], 0, 0, 0); __builtin_amdgcn_s_setprio(0); } while (0)
#define PG8_WAIT_V(n) asm volatile("s_waitcnt vmcnt(" #n ")" ::: "memory")
#define PG8_WAIT_L(n) asm volatile("s_waitcnt lgkmcnt(" #n ")" ::: "memory")
#define PG8_BAR __builtin_amdgcn_s_barrier()
#define PG8_SCHED __builtin_amdgcn_sched_barrier(0)
    Unit cur, nxt; int ui = 0;
    if (!S.next(0, cur)) return;
    f32x4 acc[2][2][4][2];
#pragma unroll
    for (int a = 0; a < 2; ++a)
#pragma unroll
        for (int b = 0; b < 2; ++b)
#pragma unroll
            for (int m = 0; m < 4; ++m)
#pragma unroll
                for (int n = 0; n < 2; ++n) acc[a][b][m][n] = (f32x4){0.f, 0.f, 0.f, 0.f};
    bf16x8 At[4][2], B0[2][2], B1[2][2];
    const char* cA = (const char*)g.A + (size_t)cur.pm * tstep; const char* cB = (const char*)g.Bt + (size_t)cur.pn * tstep;
    S.a_ready(cur);
    if constexpr (SP2) {
        PG8_STAGE(PG8_SB(0, 0), cB, voffB); PG8_STAGE(PG8_SB(0, 1), cB + hstep, voffB); PG8_STAGE(PG8_SA(0, 0), cA, voffA); PG8_STAGE(PG8_SA(0, 1), cA + hstep, voffA);
        if (wr == 1) PG8_BAR;
        PG8_WAIT_V(2); PG8_BAR;
        PG8_STAGE(PG8_SB(1, 0), cB + kstep, voffB); PG8_STAGE(PG8_SA(1, 0), cA + kstep, voffA); PG8_STAGE(PG8_SB(1, 1), cB + hstep + kstep, voffB);
        PG8_WAIT_V(6); PG8_BAR;
    } else {
        PG8_STAGE(PG8_SB(0, 0), cB, voffB); PG8_STAGE(PG8_SA(0, 0), cA, voffA); PG8_STAGE(PG8_SB(0, 1), cB + hstep, voffB); PG8_STAGE(PG8_SA(0, 1), cA + hstep, voffA);
        if (wr == 1) PG8_BAR;
        PG8_WAIT_V(4); PG8_BAR;
        PG8_STAGE(PG8_SB(1, 0), cB + kstep, voffB); PG8_STAGE(PG8_SA(1, 0), cA + kstep, voffA); PG8_STAGE(PG8_SB(1, 1), cB + hstep + kstep, voffB);
        PG8_WAIT_V(6); PG8_BAR;
    }
    for (;;) {
        const bool has_next = S.next(ui + 1, nxt);
        const char* nA = has_next ? (const char*)g.A + (size_t)nxt.pm * tstep : cA; const char* nB = has_next ? (const char*)g.Bt + (size_t)nxt.pn * tstep : cB;
        for (int t = 0; t < nt; t += 2) {
            const bool last = (t == nt - 2);
            const char* a1 = cA + (size_t)(t + 1) * kstep;
            const char* a2 = last ? nA : cA + (size_t)(t + 2) * kstep; const char* b2 = last ? nB : cB + (size_t)(t + 2) * kstep;
            const char* a3 = a2 + kstep; const char* b3 = b2 + kstep;
            if (last && has_next) S.a_ready(nxt);
            if constexpr (SP2) {
            PG8_LDB(B0, 0, 0); PG8_LDB(B1, 0, 1); PG8_SCHED; PG8_LDA(At, 0, 0); PG8_STAGE(PG8_SA(1, 1), a1 + hstep, voffA);
            PG8_WAIT_V(8); PG8_WAIT_L(0); PG8_BAR; PG8_MMA(0, 0, At, B0); PG8_MMA(0, 1, At, B1); PG8_BAR; PG8_SCHED;
            PG8_LDA(At, 0, 1); PG8_STAGE(PG8_SB(0, 0), b2, voffB); PG8_STAGE(PG8_SB(0, 1), b2 + hstep, voffB); PG8_STAGE(PG8_SA(0, 0), a2, voffA);
            PG8_WAIT_V(8); PG8_WAIT_L(0); PG8_BAR; PG8_MMA(1, 0, At, B0); PG8_MMA(1, 1, At, B1); PG8_BAR; PG8_SCHED;
            PG8_LDB(B0, 1, 0); PG8_LDB(B1, 1, 1); PG8_SCHED; PG8_LDA(At, 1, 0); PG8_STAGE(PG8_SA(0, 1), a2 + hstep, voffA);
            PG8_WAIT_V(8); PG8_WAIT_L(0); PG8_BAR; PG8_MMA(0, 0, At, B0); PG8_MMA(0, 1, At, B1); PG8_BAR; PG8_SCHED;
            PG8_LDA(At, 1, 1); PG8_STAGE(PG8_SB(1, 0), b3, voffB); PG8_STAGE(PG8_SB(1, 1), b3 + hstep, voffB); PG8_STAGE(PG8_SA(1, 0), a3, voffA);
            PG8_WAIT_V(8); PG8_WAIT_L(0); PG8_BAR; PG8_MMA(1, 0, At, B0); PG8_MMA(1, 1, At, B1); PG8_BAR; PG8_SCHED;
            } else {
            PG8_LDB(B0, 0, 0); PG8_SCHED; PG8_LDA(At, 0, 0); PG8_STAGE(PG8_SA(1, 1), a1 + hstep, voffA);
            PG8_WAIT_L(8); PG8_BAR; PG8_WAIT_L(0); PG8_MMA(0, 0, At, B0); PG8_BAR; PG8_SCHED;
            PG8_LDB(B1, 0, 1); PG8_STAGE(PG8_SB(0, 0), b2, voffB);
            PG8_BAR; PG8_WAIT_L(0); PG8_MMA(0, 1, At, B1); PG8_BAR;
            PG8_LDA(At, 0, 1); PG8_STAGE(PG8_SA(0, 0), a2, voffA);
            PG8_BAR; PG8_WAIT_L(0); PG8_MMA(1, 0, At, B0); PG8_BAR; PG8_SCHED;
            PG8_STAGE(PG8_SB(0, 1), b2 + hstep, voffB);
            PG8_WAIT_V(6); PG8_BAR; PG8_MMA(1, 1, At, B1); PG8_BAR;
            PG8_LDB(B0, 1, 0); PG8_SCHED; PG8_LDA(At, 1, 0); PG8_STAGE(PG8_SA(0, 1), a2 + hstep, voffA);
            PG8_WAIT_L(8); PG8_BAR; PG8_WAIT_L(0); PG8_MMA(0, 0, At, B0); PG8_BAR; PG8_SCHED;
            PG8_LDB(B1, 1, 1); PG8_STAGE(PG8_SB(1, 0), b3, voffB);
            PG8_BAR; PG8_WAIT_L(0); PG8_MMA(0, 1, At, B1); PG8_BAR;
            PG8_LDA(At, 1, 1); PG8_STAGE(PG8_SA(1, 0), a3, voffA);
            PG8_BAR; PG8_WAIT_L(0); PG8_MMA(1, 0, At, B0); PG8_BAR; PG8_SCHED;
            PG8_STAGE(PG8_SB(1, 1), b3 + hstep, voffB);
            PG8_WAIT_V(6); PG8_BAR; PG8_MMA(1, 1, At, B1); PG8_BAR;
            }
        }
        if constexpr (ALIGN_EPI) { if (wr == 0) PG8_BAR; }
        if constexpr (!Epi::AFTER_DRAIN) { E(acc, cur, wr, wc, fr, fq); S.done(cur); }
        if (!has_next) break;
#pragma unroll
        for (int a = 0; a < 2; ++a)
#pragma unroll
            for (int b = 0; b < 2; ++b)
#pragma unroll
                for (int m = 0; m < 4; ++m)
#pragma unroll
                    for (int n = 0; n < 2; ++n) acc[a][b][m][n] = (f32x4){0.f, 0.f, 0.f, 0.f};
        cur = nxt; cA = nA; cB = nB; ++ui;
        if constexpr (ALIGN_EPI) { if (wr == 1) PG8_BAR; }
    }
    PG8_WAIT_V(0);
    if constexpr (!ALIGN_EPI) { if (wr == 0) PG8_BAR; }
    PG8_BAR;
    if constexpr (Epi::AFTER_DRAIN) { E.fused(acc, cur, wr, wc, fr, fq, lds, wid, lane); S.done(cur); }
#undef PG8_SA
#undef PG8_SB
#undef PG8_STAGE
#undef PG8_LDA
#undef PG8_LDB
#undef PG8_MMA
#undef PG8_WAIT_V
#undef PG8_WAIT_L
#undef PG8_BAR
#undef PG8_SCHED
}
}

constexpr size_t OG_STRIDE = (size_t)MROWS * 512;
constexpr size_t LSE_STRIDE = (size_t)MROWS * 8;
constexpr int LDS_BYTES = 147456;
constexpr int NTHREADS = 512;

struct Args {
    const float* x_prompt; const float* x_sample; const float* cache0; const float* cache1; const float* cache2; const float* c_prompt; const float* c_sample;
    const float* w_ada; const float* b_ada; const float* norm_g; const float* w_in; const float* gm_ln_g; const float* gm_ln_b; const float* gm_ws; const float* gm_bs;
    const float* w_gm_out; const float* w_att_out; const float* w_o; const float* final_g;
    float* out; unsigned char* ws;
};
constexpr int PTAB_OFF = 131072 + 1024;
struct PT {
    LAS const unsigned long long* t;
    __device__ __forceinline__ unsigned long long g(int i) const { const unsigned long long v = t[i]; const unsigned lo = __builtin_amdgcn_readfirstlane((unsigned)v), hi = __builtin_amdgcn_readfirstlane((unsigned)(v >> 32)); return ((unsigned long long)hi << 32) | lo; }
#define GASP(v) ((__attribute__((address_space(1))) unsigned char*)(v))
#define PTF(name, idx) __device__ __forceinline__ const float* name() const { return (const float*)GASP(g(idx)); }
    PTF(x_prompt, 0) PTF(x_sample, 1) PTF(cache0, 2) PTF(cache1, 3) PTF(cache2, 4) PTF(c_prompt, 5) PTF(c_sample, 6) PTF(w_ada, 7) PTF(b_ada, 8) PTF(norm_g, 9) PTF(w_in, 10)
    PTF(gm_ln_g, 11) PTF(gm_ln_b, 12) PTF(gm_ws, 13) PTF(gm_bs, 14) PTF(w_gm_out, 15) PTF(w_att_out, 16) PTF(w_o, 17) PTF(final_g, 18)
#undef PTF
    __device__ __forceinline__ float* out() const { return (float*)GASP(g(19)); }
    __device__ __forceinline__ unsigned char* ws() const { return (unsigned char*)GASP(g(20)); }
};
__device__ const float INV_FREQ[32] = {1.000000000e+00f, 7.498942614e-01f, 5.623413324e-01f, 4.216965139e-01f, 3.162277639e-01f, 2.371373773e-01f, 1.778279394e-01f, 1.333521307e-01f, 1.000000015e-01f, 7.498941571e-02f, 5.623413250e-02f, 4.216965288e-02f, 3.162277490e-02f, 2.371373773e-02f, 1.778279431e-02f, 1.333521493e-02f, 9.999999776e-03f, 7.498941850e-03f, 5.623413250e-03f, 4.216964822e-03f, 3.162277630e-03f, 2.371373586e-03f, 1.778279431e-03f, 1.333521446e-03f, 1.000000047e-03f, 7.498942432e-04f, 5.623413017e-04f, 4.216965172e-04f, 3.162277571e-04f, 2.371373703e-04f, 1.778279402e-04f, 1.333521504e-04f};

__device__ __forceinline__ float wave_sum(float v) {
#pragma unroll
    for (int o = 1; o < 64; o <<= 1) v += __shfl_xor(v, o);
    return v;
}

template <bool PROJ_ORDER> __device__ __forceinline__ void p0_transpose_item(const float* W, int K, int N, bf16* WT, LAS float* scr, int item, int lane) {
    const int nblk = N / 32, kb = item / nblk, nb = item % nblk, k0 = 64 * kb, n0 = 32 * nb, ns = PROJ_ORDER ? proj_src_col32(nb) : n0;
#pragma unroll 8
    for (int i = 0; i < 32; ++i) { const int kk = 2 * i + (lane >> 5); scr[kk * 33 + (lane & 31)] = W[(size_t)(k0 + kk) * N + ns + (lane & 31)]; }
    asm volatile("s_waitcnt lgkmcnt(0)" ::: "memory");
    const int c = lane & 7;
#pragma unroll
    for (int j = 0; j < 4; ++j) { const int n = (lane >> 3) + 8 * j; const LAS float* s = scr + (8 * c) * 33 + n;
        u32x4 o; o.x = pk2(s[0 * 33], s[1 * 33]); o.y = pk2(s[2 * 33], s[3 * 33]); o.z = pk2(s[4 * 33], s[5 * 33]); o.w = pk2(s[6 * 33], s[7 * 33]);
        *(u32x4*)(WT + (size_t)(n0 + n) * K + k0 + 8 * c) = o; }
    asm volatile("s_waitcnt lgkmcnt(0)" ::: "memory");
}

__device__ __forceinline__ void p0_mod_item(const PT& a, LAS unsigned char* lds, int item, int tid) {
    const float* c_prompt_ = a.c_prompt(); const float* c_sample_ = a.c_sample(); const float* w_ada_ = a.w_ada(); const float* b_ada_ = a.b_ada(); unsigned char* ws_ = a.ws();
    const int wave = tid >> 6, lane = tid & 63;
    const int rg = item % 3; const int r2 = item / 3; const int cb = r2 % 48; const int l = r2 / 48;
    const int row0 = rg * 16, col = cb * 64 + lane, k0 = wave * 128;
    LAS float* tab = (LAS float*)(lds + wave * 8192);
    for (int e = lane; e < 2048; e += 64) { const int rr = e >> 7, kk = e & 127; const int cr = row0 + rr;
        const float* cp = cr < NBATCH ? c_prompt_ + (size_t)cr * 1024 : c_sample_ + (size_t)(cr - NBATCH) * 1024; tab[e] = siluf_(cp[k0 + kk]); }
    asm volatile("s_waitcnt lgkmcnt(0)" ::: "memory");
    float acc[16];
#pragma unroll
    for (int r = 0; r < 16; ++r) acc[r] = 0.f;
    const float* wp = w_ada_ + (size_t)l * 1024 * 3072 + (size_t)k0 * 3072 + col;
#pragma unroll 2
    for (int kk = 0; kk < 128; kk += 4) {
        const float w0 = wp[(size_t)(kk + 0) * 3072], w1 = wp[(size_t)(kk + 1) * 3072], w2 = wp[(size_t)(kk + 2) * 3072], w3 = wp[(size_t)(kk + 3) * 3072];
#pragma unroll
        for (int r = 0; r < 16; ++r) { const f32x4 t = *(const LAS f32x4*)(tab + r * 128 + kk); acc[r] += (t[0] * w0 + t[1] * w1) + (t[2] * w2 + t[3] * w3); }
    }
    LAS float* red = (LAS float*)(lds + 65536);
#pragma unroll
    for (int r = 0; r < 16; ++r) red[(wave * 16 + r) * 64 + lane] = acc[r];
    __syncthreads();
    float* mod = (float*)(ws_ + WS_MOD);
    for (int e = tid; e < 1024; e += NTHREADS) { const int rr = e >> 6, cc = e & 63; float s = 0.f;
#pragma unroll
        for (int w = 0; w < 8; ++w) s += red[(w * 16 + rr) * 64 + cc];
        const int colg = cb * 64 + cc; mod[((size_t)l * NCOND + row0 + rr) * 3072 + colg] = s + b_ada_[l * 3072 + colg]; }
    __syncthreads();
}

__device__ __forceinline__ void p0_phase(const PT& a, LAS unsigned char* lds, int tid, int bid, int G) {
    const float* w_in_ = a.w_in(); const float* w_gm_out_ = a.w_gm_out(); const float* w_att_out_ = a.w_att_out(); const float* w_o_ = a.w_o(); unsigned char* ws_ = a.ws();
    const int wave = tid >> 6, lane = tid & 63;
    for (int it = bid; it < 288; it += G) p0_mod_item(a, lds, it, tid);
    { f32x2* rt = (f32x2*)(ws_ + WS_ROPE);
      for (int e = bid * NTHREADS + tid; e < 2056 * 32; e += G * NTHREADS) { const int pi = e >> 5, i = e & 31; const int pos = pi < SEQ ? pi : PAST + (pi - SEQ);
          const float ang = (float)pos * INV_FREQ[i]; const double rv = (double)ang * 0.15915494309189535; const float f = (float)(rv - rint(rv));
          f32x2 cs; cs.x = __builtin_amdgcn_cosf(f); cs.y = __builtin_amdgcn_sinf(f); rt[e] = cs; } }
    { const float* gm_ws_ = a.gm_ws(); bf16* wmb = (bf16*)(ws_ + WS_WMB);
      for (int e = bid * NTHREADS + tid; e < 2 * 8 * 16384; e += G * NTHREADS) { const int sidx = e & 127, tt = (e >> 7) & 127; wmb[e] = sidx <= tt ? (bf16)f2bf(gm_ws_[e]) : (bf16)0; } }
    LAS float* scr = (LAS float*)(lds + wave * 16384);
    const int gw = bid * 8 + wave, NGW = G * 8;
    constexpr int I_IN = 16 * 320, I_GM = 16 * 32, I_ATT = 8 * 32, I_O = 16 * 32, I_L = I_IN + I_GM + I_ATT + I_O;
    for (int it = gw; it < 2 * I_L; it += NGW) {
        const int l = it / I_L; int r = it % I_L;
        if (r < I_IN) { p0_transpose_item<true>(w_in_ + (size_t)l * 1024 * NPROJ, 1024, NPROJ, (bf16*)(ws_ + WS_WTIN) + (size_t)l * NPROJ * 1024, scr, r, lane); continue; } r -= I_IN;
        if (r < I_GM) { p0_transpose_item<false>(w_gm_out_ + (size_t)l * 1024 * 1024, 1024, 1024, (bf16*)(ws_ + WS_WTGM) + (size_t)l * 1024 * 1024, scr, r, lane); continue; } r -= I_GM;
        if (r < I_ATT) { p0_transpose_item<false>(w_att_out_ + (size_t)l * 512 * 1024, 512, 1024, (bf16*)(ws_ + WS_WTATT) + (size_t)l * 1024 * 512, scr, r, lane); continue; } r -= I_ATT;
        p0_transpose_item<false>(w_o_ + (size_t)l * 1024 * 1024, 1024, 1024, (bf16*)(ws_ + WS_WTO) + (size_t)l * 1024 * 1024, scr, r, lane);
    }
}

__device__ __forceinline__ void norm_phase(const PT& a, int l  , const float* xbuf  , int tid, int bid, int G) {
    const float* x_prompt_ = a.x_prompt(); const float* x_sample_ = a.x_sample(); const float* norm_g_ = a.norm_g(); const float* final_g_ = a.final_g(); float* out_ = a.out(); unsigned char* ws_ = a.ws();
    const int wave = tid >> 6, lane = tid & 63; const int gw = bid * 8 + wave, NGW = G * 8;
    const float* mod = (const float*)(ws_ + WS_MOD);
    bf16* H = (bf16*)(ws_ + WS_H);
    for (int m = gw; m < MROWS; m += NGW) {
        const float* xr = xbuf ? xbuf + (size_t)m * 1024 : (m < MP ? x_prompt_ + (size_t)m * 1024 : x_sample_ + (size_t)(m - MP) * 1024);
        f32x4 v[4]; float ss = 0.f;
#pragma unroll
        for (int j = 0; j < 4; ++j) { v[j] = *(const f32x4*)(xr + 4 * lane + 256 * j); ss += (v[j][0] * v[j][0] + v[j][1] * v[j][1]) + (v[j][2] * v[j][2] + v[j][3] * v[j][3]); }
        const float rstd = 1.0f / sqrtf(wave_sum(ss) * (1.0f / 1024.0f) + 1e-6f);
        if (l < 2) {
            const float* mr = mod + ((size_t)l * NCOND + cond_row(m)) * 3072;
#pragma unroll
            for (int j = 0; j < 4; ++j) { const int c = 4 * lane + 256 * j; const f32x4 g = *(const f32x4*)(norm_g_ + l * 1024 + c), sh = *(const f32x4*)(mr + c), sc = *(const f32x4*)(mr + 1024 + c);
                const f32x4 h = (v[j] * rstd) * g * (sc + 1.0f) + sh; u32x2 w; w.x = pk2(h[0], h[1]); w.y = pk2(h[2], h[3]); *(u32x2*)(H + (size_t)m * 1024 + c) = w; }
        } else {
#pragma unroll
            for (int j = 0; j < 4; ++j) { const int c = 4 * lane + 256 * j; const f32x4 g = *(const f32x4*)(final_g_ + c); *(f32x4*)(out_ + O_Y + (size_t)m * 1024 + c) = (v[j] * rstd) * g; }
        }
    }
}

typedef short bf16x8_t __attribute__((ext_vector_type(8)));
typedef float f32x16 __attribute__((ext_vector_type(16)));
typedef short s16x4_t __attribute__((ext_vector_type(4)));
__device__ __forceinline__ s16x4_t vtr(LAS const unsigned char* p) { return __builtin_bit_cast(s16x4_t, __builtin_amdgcn_ds_read_tr16_b64_v4i16((LAS s16x4_t*)p)); }
__device__ __forceinline__ void spatial_item(const PT& a, int l, int ci, LAS unsigned char* lds, int tid) {
    unsigned char* ws_ = a.ws(); const float* lng_ = a.gm_ln_g() + l * 1024; const float* lnb_ = a.gm_ln_b() + l * 1024; const float* bs_ = a.gm_bs() + (size_t)l * 1024; float* out_ = a.out();
    const int wave = __builtin_amdgcn_readfirstlane(tid >> 6), lane = tid & 63;
    const int m0 = ci < 256 ? ci * 128 : MP + (ci - 256) * 8, nrows = ci < 256 ? 128 : 8;
    const bf16* GV = (const bf16*)(ws_ + WS_GV); const bf16* UZ = (const bf16*)(ws_ + WS_UZ); bf16* YA = (bf16*)(ws_ + WS_YA);
    LAS f32x2* stat = (LAS f32x2*)(lds + 131072);
    { const int nper = nrows >> 3;
      for (int rr = 0; rr < nper; ++rr) { const int row = wave * nper + rr; const bf16* pr = GV + (size_t)(m0 + row) * 1024;
          float gv[16]; float sm = 0.f;
#pragma unroll
          for (int j = 0; j < 2; ++j) { const u32x4 w = *(const u32x4*)(pr + 8 * lane + 512 * j);
              gv[8 * j + 0] = bflo(w.x); gv[8 * j + 1] = bfhi(w.x); gv[8 * j + 2] = bflo(w.y); gv[8 * j + 3] = bfhi(w.y);
              gv[8 * j + 4] = bflo(w.z); gv[8 * j + 5] = bfhi(w.z); gv[8 * j + 6] = bflo(w.w); gv[8 * j + 7] = bfhi(w.w); }
#pragma unroll
          for (int i = 0; i < 16; ++i) sm += gv[i];
          const float mu = wave_sum(sm) * (1.0f / 1024.0f); float q = 0.f;
#pragma unroll
          for (int i = 0; i < 16; ++i) { const float dlt = gv[i] - mu; q += dlt * dlt; }
          const float rstd = 1.0f / sqrtf(wave_sum(q) * (1.0f / 1024.0f) + 1e-5f);
          if (lane == 0) stat[row] = (f32x2){mu, rstd};
          if (nrows == 8) {
#pragma unroll
              for (int j = 0; j < 2; ++j) { const int c = 8 * lane + 512 * j; float o[8];
#pragma unroll
                  for (int i = 0; i < 8; ++i) o[i] = (gv[8 * j + i] - mu) * rstd * lng_[c + i] + lnb_[c + i];
                  float* go = out_ + O_GMV + ((size_t)l * MS + (m0 - MP + row)) * 1024 + c; *(f32x4*)go = (f32x4){o[0], o[1], o[2], o[3]}; *(f32x4*)(go + 4) = (f32x4){o[4], o[5], o[6], o[7]}; } }
      } }
    __syncthreads();
    { const int g = wave, t32 = lane & 31, hi = lane >> 5; LAS unsigned char* img = lds + wave * 16384;
      const bf16* wmb = (const bf16*)(ws_ + WS_WMB) + ((size_t)l * 8 + g) * 16384;
      for (int hf = 0; hf < 2; ++hf) { const int col0 = g * 128 + hf * 64, c = lane & 7;
          float lg[8], lb[8];
#pragma unroll
          for (int i = 0; i < 8; ++i) { lg[i] = lng_[col0 + 8 * c + i]; lb[i] = lnb_[col0 + 8 * c + i]; }
#pragma unroll 4
          for (int i = 0; i < 16; ++i) { const int row = 8 * i + (lane >> 3); u32x4 w = (u32x4){0u, 0u, 0u, 0u};
              if (row < nrows) { const u32x4 x = *(const u32x4*)(GV + (size_t)(m0 + row) * 1024 + col0 + 8 * c); const f32x2 st = stat[row];
                  w.x = pk2((bflo(x.x) - st.x) * st.y * lg[0] + lb[0], (bfhi(x.x) - st.x) * st.y * lg[1] + lb[1]);
                  w.y = pk2((bflo(x.y) - st.x) * st.y * lg[2] + lb[2], (bfhi(x.y) - st.x) * st.y * lg[3] + lb[3]);
                  w.z = pk2((bflo(x.z) - st.x) * st.y * lg[4] + lb[4], (bfhi(x.z) - st.x) * st.y * lg[5] + lb[5]);
                  w.w = pk2((bflo(x.w) - st.x) * st.y * lg[6] + lb[6], (bfhi(x.w) - st.x) * st.y * lg[7] + lb[7]); }
              *(LAS u32x4*)(img + (c >> 2) * 8192 + row * 64 + (c & 3) * 16) = w; }
          const int gidx = lane >> 4, qp = (lane & 15) >> 2, pp = lane & 3;
          LAS const unsigned char* rp = img + (8 * (gidx >> 1) + qp) * 64 + (16 * (gidx & 1) + 4 * pp) * 2;
          const int ntt = nrows == 128 ? 4 : 1;
#pragma unroll
          for (int tt = 0; tt < 4; ++tt) { if (tt < ntt) {
              bf16x8_t bfr[8];
#pragma unroll
              for (int ks = 0; ks < 2 * tt + 2; ++ks) bfr[ks] = *(const bf16x8_t*)(wmb + (size_t)(32 * tt + t32) * 128 + 16 * ks + 8 * hi);
              const int t = 32 * tt + t32; const float bsv = bs_[g * 128 + (t < 128 ? t : 0)];
#pragma unroll
              for (int dhh = 0; dhh < 2; ++dhh) { f32x16 acc;
#pragma unroll
                  for (int j = 0; j < 16; ++j) acc[j] = 0.f;
#pragma unroll
                  for (int ks = 0; ks < 2 * tt + 2; ++ks) { const s16x4_t lo = vtr(rp + dhh * 8192 + ks * 1024), hi4 = vtr(rp + dhh * 8192 + ks * 1024 + 256);
                      const bf16x8_t af = (bf16x8_t){lo[0], lo[1], lo[2], lo[3], hi4[0], hi4[1], hi4[2], hi4[3]};
                      acc = __builtin_amdgcn_mfma_f32_32x32x16_bf16(af, bfr[ks], acc, 0, 0, 0); }
                  if (t < nrows) { const size_t m = (size_t)(m0 + t);
#pragma unroll
                      for (int j4 = 0; j4 < 4; ++j4) { const int dcol = col0 + dhh * 32 + 8 * j4 + 4 * hi;
                          const u32x2 uw = *(const u32x2*)(UZ + m * 1024 + dcol);
                          u32x2 o; o.x = pk2(bflo(uw.x) * (acc[4 * j4 + 0] + bsv), bfhi(uw.x) * (acc[4 * j4 + 1] + bsv)); o.y = pk2(bflo(uw.y) * (acc[4 * j4 + 2] + bsv), bfhi(uw.y) * (acc[4 * j4 + 3] + bsv));
                          *(u32x2*)(YA + m * 1024 + dcol) = o; } }
              } } }
      } }
    __syncthreads();
}
__device__ __forceinline__ void spatial_phase(const PT& a, int l, LAS unsigned char* lds, int tid, int bid, int G) {
    for (int it = bid; it < 256 + DBATCH; it += G) spatial_item(a, l, it, lds, tid);
}

__device__ __forceinline__ int crow(int j, int hi) { return (j & 3) + 8 * (j >> 2) + 4 * hi; }
__device__ __forceinline__ unsigned cvtpk(float lo, float hi) { unsigned r; asm volatile("v_cvt_pk_bf16_f32 %0, %1, %2" : "=v"(r) : "v"(lo), "v"(hi)); return r; }
constexpr float ATT_SCALE2 = 0.125f * 1.4426950408889634f;

template <int NT> __device__ __forceinline__ void attn_unit(const bf16* Qb, const bf16* Kb, const bf16* Vb, int pitch, int dil, int r, int qt, bf16* Og, float* Lg, LAS unsigned char* vst, int lane) {
    const int q32 = lane & 31, hi = lane >> 5;
    const size_t qtok = (size_t)((32 * qt + q32) * dil + r);
    bf16x8_t qf[4];
#pragma unroll
    for (int ks = 0; ks < 4; ++ks) qf[ks] = *(const bf16x8_t*)(Qb + qtok * pitch + 16 * ks + 8 * hi);
    f32x16 st[NT];
#pragma unroll
    for (int ti = 0; ti < NT; ++ti) { const int kt = qt - (NT - 1) + ti;
        const bf16* kp = Kb + (size_t)((32 * kt + q32) * dil + r) * pitch + 8 * hi;
        const bf16x8_t k0 = *(const bf16x8_t*)kp, k1 = *(const bf16x8_t*)(kp + 16), k2 = *(const bf16x8_t*)(kp + 32), k3 = *(const bf16x8_t*)(kp + 48);
        f32x16 acc;
#pragma unroll
        for (int j = 0; j < 16; ++j) acc[j] = 0.f;
        acc = __builtin_amdgcn_mfma_f32_32x32x16_bf16(k0, qf[0], acc, 0, 0, 0); acc = __builtin_amdgcn_mfma_f32_32x32x16_bf16(k1, qf[1], acc, 0, 0, 0);
        acc = __builtin_amdgcn_mfma_f32_32x32x16_bf16(k2, qf[2], acc, 0, 0, 0); acc = __builtin_amdgcn_mfma_f32_32x32x16_bf16(k3, qf[3], acc, 0, 0, 0);
#pragma unroll
        for (int j = 0; j < 16; ++j) { const int cr = crow(j, hi); bool valid = true;
            if (NT == 5 && ti == 0) valid = cr >= q32;
            if (ti == NT - 1) valid = valid && (cr <= q32);
            st[ti][j] = valid ? acc[j] * ATT_SCALE2 : -1e30f; }
    }
    float mx = -1e30f;
#pragma unroll
    for (int ti = 0; ti < NT; ++ti)
#pragma unroll
        for (int j = 0; j < 16; ++j) mx = fmaxf(mx, st[ti][j]);
    mx = fmaxf(mx, __shfl_xor(mx, 32));
    float lsum = 0.f;
#pragma unroll
    for (int ti = 0; ti < NT; ++ti)
#pragma unroll
        for (int j = 0; j < 16; ++j) { st[ti][j] = __builtin_amdgcn_exp2f(st[ti][j] - mx); lsum += st[ti][j]; }
    lsum += __shfl_xor(lsum, 32);
    f32x16 o[2];
#pragma unroll
    for (int j = 0; j < 16; ++j) { o[0][j] = 0.f; o[1][j] = 0.f; }
#pragma unroll
    for (int ti = 0; ti < NT; ++ti) { const int kt = qt - (NT - 1) + ti; LAS unsigned char* img = vst + (ti & 1) * 4096;
#pragma unroll
        for (int jj = 0; jj < 4; ++jj) { const int key = 8 * jj + (lane >> 3), c = lane & 7;
            const u32x4 vv = *(const u32x4*)(Vb + (size_t)((32 * kt + key) * dil + r) * pitch + 8 * c);
            *(LAS u32x4*)(img + (c >> 2) * 2048 + key * 64 + (c & 3) * 16) = vv; }
#pragma unroll
        for (int ks2 = 0; ks2 < 2; ++ks2) {
            u32x4 pw; pw.x = cvtpk(st[ti][8 * ks2 + 0], st[ti][8 * ks2 + 1]); pw.y = cvtpk(st[ti][8 * ks2 + 2], st[ti][8 * ks2 + 3]); pw.z = cvtpk(st[ti][8 * ks2 + 4], st[ti][8 * ks2 + 5]); pw.w = cvtpk(st[ti][8 * ks2 + 6], st[ti][8 * ks2 + 7]);
            const bf16x8_t pf = __builtin_bit_cast(bf16x8_t, pw);
            const int gidx = lane >> 4, qp = (lane & 15) >> 2, pp = lane & 3;
            LAS const unsigned char* rp = img + (16 * ks2 + 4 * (gidx >> 1) + qp) * 64 + (16 * (gidx & 1) + 4 * pp) * 2;
#pragma unroll
            for (int dh = 0; dh < 2; ++dh) { const s16x4_t lo = vtr(rp + dh * 2048), hi4 = vtr(rp + dh * 2048 + 8 * 64);
                const bf16x8_t vf = (bf16x8_t){lo[0], lo[1], lo[2], lo[3], hi4[0], hi4[1], hi4[2], hi4[3]};
                o[dh] = __builtin_amdgcn_mfma_f32_32x32x16_bf16(vf, pf, o[dh], 0, 0, 0); }
        }
    }
    const float inv = 1.0f / lsum; bf16* op = Og + qtok * 512;
#pragma unroll
    for (int dh = 0; dh < 2; ++dh)
#pragma unroll
        for (int j4 = 0; j4 < 4; ++j4) { u32x2 w; w.x = cvtpk(o[dh][4 * j4 + 0] * inv, o[dh][4 * j4 + 1] * inv); w.y = cvtpk(o[dh][4 * j4 + 2] * inv, o[dh][4 * j4 + 3] * inv);
            *(u32x2*)(op + 32 * dh + 8 * j4 + 4 * hi) = w; }
    if (hi == 0) Lg[qtok * 8] = (mx + __builtin_amdgcn_logf(lsum)) * 0.6931471805599453f;
}

__device__ __forceinline__ void attn_prompt_item(const PT& a, int item, LAS unsigned char* lds, int tid) {
    unsigned char* ws_ = a.ws();
    const int wave = __builtin_amdgcn_readfirstlane(tid >> 6), lane = tid & 63; const int c = item & 3, h = (item >> 2) & 7, b = item >> 5;
    const size_t qoff = (size_t)b * SEQ * 1536 + h * 64; bf16* OG = (bf16*)(ws_ + WS_OG) + (size_t)b * SEQ * 512 + h * 64; float* LSE = (float*)(ws_ + WS_LSE) + (size_t)b * SEQ * 8 + h;
    LAS unsigned char* vst = lds + wave * 8192;
    for (int i = 0; i < 6; ++i) { const int u = wave + 8 * i, g = u >> 4, j = u & 15;
        int dil, r, qt; if (g == 0) { dil = 1; r = 0; qt = 16 * c + j; } else if (g == 1) { dil = 4; r = j >> 2; qt = 4 * c + (j & 3); } else { dil = 16; r = j; qt = c; }
        const bf16* Qb = (const bf16*)(ws_ + WS_Q) + qoff + g * 512; const bf16* Kb = (const bf16*)(ws_ + WS_K) + qoff + g * 512; const bf16* Vb = (const bf16*)(ws_ + WS_V) + qoff + g * 512;
        bf16* Og = OG + (size_t)g * OG_STRIDE; float* Lg = LSE + (size_t)g * LSE_STRIDE;
        const int nt = qt >= 4 ? 5 : qt + 1;
        switch (nt) {
            case 1: attn_unit<1>(Qb, Kb, Vb, 1536, dil, r, qt, Og, Lg, vst, lane); break;
            case 2: attn_unit<2>(Qb, Kb, Vb, 1536, dil, r, qt, Og, Lg, vst, lane); break;
            case 3: attn_unit<3>(Qb, Kb, Vb, 1536, dil, r, qt, Og, Lg, vst, lane); break;
            case 4: attn_unit<4>(Qb, Kb, Vb, 1536, dil, r, qt, Og, Lg, vst, lane); break;
            default: attn_unit<5>(Qb, Kb, Vb, 1536, dil, r, qt, Og, Lg, vst, lane); break;
        }
    }
    __syncthreads();
    { const size_t t = (size_t)(512 * c + tid); const float l0 = LSE[t * 8], l1 = LSE[LSE_STRIDE + t * 8], l2 = LSE[2 * LSE_STRIDE + t * 8];
      const float mx = fmaxf(l0, fmaxf(l1, l2)); float w0 = __expf(l0 - mx), w1 = __expf(l1 - mx), w2 = __expf(l2 - mx); const float inv = 1.0f / (w0 + w1 + w2); w0 *= inv; w1 *= inv; w2 *= inv;
      const bf16* zp = (const bf16*)(ws_ + WS_ZB) + ((size_t)b * SEQ + t) * 512 + h * 64; bf16* yp = (bf16*)(ws_ + WS_YB) + ((size_t)b * SEQ + t) * 512 + h * 64;
#pragma unroll 2
      for (int k8 = 0; k8 < 8; ++k8) {
          const u32x4 a0 = *(const u32x4*)(OG + t * 512 + 8 * k8), a1 = *(const u32x4*)(OG + OG_STRIDE + t * 512 + 8 * k8), a2 = *(const u32x4*)(OG + 2 * OG_STRIDE + t * 512 + 8 * k8), zb = *(const u32x4*)(zp + 8 * k8);
          u32x4 o;
          o.x = pk2((w0 * bflo(a0.x) + w1 * bflo(a1.x) + w2 * bflo(a2.x)) * bflo(zb.x), (w0 * bfhi(a0.x) + w1 * bfhi(a1.x) + w2 * bfhi(a2.x)) * bfhi(zb.x));
          o.y = pk2((w0 * bflo(a0.y) + w1 * bflo(a1.y) + w2 * bflo(a2.y)) * bflo(zb.y), (w0 * bfhi(a0.y) + w1 * bfhi(a1.y) + w2 * bfhi(a2.y)) * bfhi(zb.y));
          o.z = pk2((w0 * bflo(a0.z) + w1 * bflo(a1.z) + w2 * bflo(a2.z)) * bflo(zb.z), (w0 * bfhi(a0.z) + w1 * bfhi(a1.z) + w2 * bfhi(a2.z)) * bfhi(zb.z));
          o.w = pk2((w0 * bflo(a0.w) + w1 * bflo(a1.w) + w2 * bflo(a2.w)) * bflo(zb.w), (w0 * bfhi(a0.w) + w1 * bfhi(a1.w) + w2 * bfhi(a2.w)) * bfhi(zb.w));
          *(u32x4*)(yp + 8 * k8) = o; }
    }
}

__device__ __forceinline__ void attn_sample_item(const PT& a, int l, int item, LAS unsigned char* lds, int tid) {
    unsigned char* ws_ = a.ws(); const float* cache0_ = a.cache0(); const float* cache1_ = a.cache1(); const float* cache2_ = a.cache2();
    const int wave = __builtin_amdgcn_readfirstlane(tid >> 6), lane = tid & 63; const int b = item >> 3, t = item & 7; const int h = lane >> 3, ds = (lane & 7) * 8;
    const bf16* QA = (const bf16*)(ws_ + WS_Q); const bf16* KA = (const bf16*)(ws_ + WS_K); const bf16* VA = (const bf16*)(ws_ + WS_V); const size_t m = (size_t)MP + item;
    LAS float* PO = (LAS float*)(lds + 65536); LAS float* PM = (LAS float*)(lds + 65536 + 49152); LAS float* PL = PM + 192;
    for (int g = 0; g < 3; ++g) { const int dil = g == 0 ? 1 : g == 1 ? 4 : 16, nprev = 128 * dil;
        const float* cache = (g == 0 ? cache0_ : g == 1 ? cache1_ : cache2_) + ((size_t)l * DBATCH + b) * nprev * 1024;
        float q[8]; { const u32x4 w = *(const u32x4*)(QA + m * 1536 + g * 512 + h * 64 + ds);
            q[0] = bflo(w.x) * ATT_SCALE2; q[1] = bfhi(w.x) * ATT_SCALE2; q[2] = bflo(w.y) * ATT_SCALE2; q[3] = bfhi(w.y) * ATT_SCALE2; q[4] = bflo(w.z) * ATT_SCALE2; q[5] = bfhi(w.z) * ATT_SCALE2; q[6] = bflo(w.w) * ATT_SCALE2; q[7] = bfhi(w.w) * ATT_SCALE2; }
        float o[8];
#pragma unroll
        for (int i = 0; i < 8; ++i) o[i] = 0.f;
        float mx = -1e30f, lsum = 0.f;
        const int j0 = wave == 0 ? 0 : 16 * wave + 1, j1 = 16 * wave + 16;
        for (int jb = j0; jb <= j1; jb += 8) {
            float kf[8][8], vf[8][8];
#pragma unroll
            for (int u = 0; u < 8; ++u) { const int j = jb + u <= j1 ? jb + u : j1; const int idx = nprev + t - dil * j;
                if (idx >= nprev) { const size_t ko = ((size_t)MP + b * 8 + (idx - nprev)) * 1536 + g * 512 + h * 64 + ds; const u32x4 kw = *(const u32x4*)(KA + ko), vw = *(const u32x4*)(VA + ko);
                    kf[u][0] = bflo(kw.x); kf[u][1] = bfhi(kw.x); kf[u][2] = bflo(kw.y); kf[u][3] = bfhi(kw.y); kf[u][4] = bflo(kw.z); kf[u][5] = bfhi(kw.z); kf[u][6] = bflo(kw.w); kf[u][7] = bfhi(kw.w);
                    vf[u][0] = bflo(vw.x); vf[u][1] = bfhi(vw.x); vf[u][2] = bflo(vw.y); vf[u][3] = bfhi(vw.y); vf[u][4] = bflo(vw.z); vf[u][5] = bfhi(vw.z); vf[u][6] = bflo(vw.w); vf[u][7] = bfhi(vw.w);
                } else { const float* kp = cache + (size_t)idx * 1024 + h * 64 + ds; const f32x4 k0 = *(const f32x4*)kp, k1 = *(const f32x4*)(kp + 4), v0 = *(const f32x4*)(kp + 512), v1 = *(const f32x4*)(kp + 516);
                    kf[u][0] = k0[0]; kf[u][1] = k0[1]; kf[u][2] = k0[2]; kf[u][3] = k0[3]; kf[u][4] = k1[0]; kf[u][5] = k1[1]; kf[u][6] = k1[2]; kf[u][7] = k1[3];
                    vf[u][0] = v0[0]; vf[u][1] = v0[1]; vf[u][2] = v0[2]; vf[u][3] = v0[3]; vf[u][4] = v1[0]; vf[u][5] = v1[1]; vf[u][6] = v1[2]; vf[u][7] = v1[3]; } }
#pragma unroll
            for (int u = 0; u < 8; ++u) { if (jb + u <= j1) {
                float s = 0.f;
#pragma unroll
                for (int i = 0; i < 8; ++i) s += q[i] * kf[u][i];
                s += __shfl_xor(s, 1); s += __shfl_xor(s, 2); s += __shfl_xor(s, 4);
                const float mn = fmaxf(mx, s), corr = __builtin_amdgcn_exp2f(mx - mn), p = __builtin_amdgcn_exp2f(s - mn); mx = mn; lsum = lsum * corr + p;
#pragma unroll
                for (int i = 0; i < 8; ++i) o[i] = o[i] * corr + p * vf[u][i]; } }
        }
        const int pi = g * 8 + wave;
        *(LAS f32x4*)(PO + pi * 512 + lane * 8) = (f32x4){o[0], o[1], o[2], o[3]}; *(LAS f32x4*)(PO + pi * 512 + lane * 8 + 4) = (f32x4){o[4], o[5], o[6], o[7]};
        if ((lane & 7) == 0) { PM[pi * 8 + h] = mx; PL[pi * 8 + h] = lsum; }
    }
    __syncthreads();
    { const int hh = tid >> 6; float M = -1e30f;
#pragma unroll
      for (int p = 0; p < 24; ++p) M = fmaxf(M, PM[p * 8 + hh]);
      float L = 0.f, acc = 0.f;
#pragma unroll
      for (int p = 0; p < 24; ++p) { const float w = __builtin_amdgcn_exp2f(PM[p * 8 + hh] - M); L += w * PL[p * 8 + hh]; acc += w * PO[p * 512 + tid]; }
      const float zb = bf2f(((const bf16*)(ws_ + WS_ZB))[m * 512 + tid]);
      ((bf16*)(ws_ + WS_YB))[m * 512 + tid] = (bf16)f2bf(acc / L * zb); }
    __syncthreads();
}

__device__ __forceinline__ void attn_phase(const PT& a, int l, LAS unsigned char* lds, int tid, int bid, int G) {
    for (int it = bid; it < MS; it += G) attn_sample_item(a, l, it, lds, tid);
    for (int it = bid; it < NBATCH * 8 * 4; it += G) attn_prompt_item(a, it, lds, tid);
}


__global__ void __launch_bounds__(NTHREADS, 2) hybrid_step_fwd(Args ka) {
    extern __shared__ __attribute__((aligned(16))) unsigned char lds_raw[];
    LAS unsigned char* lds = (LAS unsigned char*)lds_raw;
    cg::grid_group grid = cg::this_grid();
    const int bid = blockIdx.x, G = gridDim.x;
    { LAS unsigned long long* pt = (LAS unsigned long long*)(lds + PTAB_OFF);
      if (threadIdx.x == 0) { pt[0] = (unsigned long long)ka.x_prompt; pt[1] = (unsigned long long)ka.x_sample; pt[2] = (unsigned long long)ka.cache0; pt[3] = (unsigned long long)ka.cache1; pt[4] = (unsigned long long)ka.cache2;
          pt[5] = (unsigned long long)ka.c_prompt; pt[6] = (unsigned long long)ka.c_sample; pt[7] = (unsigned long long)ka.w_ada; pt[8] = (unsigned long long)ka.b_ada; pt[9] = (unsigned long long)ka.norm_g;
          pt[10] = (unsigned long long)ka.w_in; pt[11] = (unsigned long long)ka.gm_ln_g; pt[12] = (unsigned long long)ka.gm_ln_b; pt[13] = (unsigned long long)ka.gm_ws; pt[14] = (unsigned long long)ka.gm_bs;
          pt[15] = (unsigned long long)ka.w_gm_out; pt[16] = (unsigned long long)ka.w_att_out; pt[17] = (unsigned long long)ka.w_o; pt[18] = (unsigned long long)ka.final_g; pt[19] = (unsigned long long)ka.out; pt[20] = (unsigned long long)ka.ws; }
      __syncthreads(); }
    PT a; a.t = (LAS const unsigned long long*)(lds + PTAB_OFF);
#define TID() ({ int t_ = threadIdx.x; asm volatile("" : "+v"(t_)); t_; })
#define WSP(T, off) ((T*)(a.ws() + (off)))

    p0_phase(a, lds, TID(), bid, G);
    grid.sync();
    norm_phase(a, 0, nullptr, TID(), bid, G);
    grid.sync();
    for (int l = 0; l < 2; ++l) {
        { pg8::Gemm g{WSP(bf16, WS_H), WSP(bf16, WS_WTIN) + (size_t)l * NPROJ * 1024, MROWS, NPROJ, 1024}; pg8::StaticOrder S; S.init(MROWS, NPROJ, G, bid);
          pg8::EpiProj E{a.ws(), a.out(), l}; pg8::gemm_phase<pg8::EpiProj, pg8::StaticOrder, true, true>(lds, g, S, E); }
        grid.sync();
        spatial_phase(a, l, lds, TID(), bid, G);
        attn_phase(a, l, lds, TID(), bid, G);
        grid.sync();
        { pg8::Gemm g{WSP(bf16, WS_YA), WSP(bf16, WS_WTGM) + (size_t)l * 1024 * 1024, MROWS, 1024, 1024}; pg8::StaticOrder S; S.init(MROWS, 1024, G, bid);
          pg8::EpiGate1 E{WSP(float, WS_T), WSP(bf16, WS_SGA), 1024}; pg8::gemm_phase<pg8::EpiGate1, pg8::StaticOrder, true, true>(lds, g, S, E); }
        { pg8::Gemm g{WSP(bf16, WS_YB), WSP(bf16, WS_WTATT) + (size_t)l * 1024 * 512, MROWS, 1024, 512}; pg8::StaticOrder S; S.init(MROWS, 1024, G, bid);
          pg8::EpiGate2 E{WSP(float, WS_T), WSP(bf16, WS_SGB), 1024, WSP(bf16, WS_MERGED)}; pg8::gemm_phase<pg8::EpiGate2, pg8::StaticOrder, true, true>(lds, g, S, E); }
        grid.sync();
        { pg8::Gemm g{WSP(bf16, WS_MERGED), WSP(bf16, WS_WTO) + (size_t)l * 1024 * 1024, MROWS, 1024, 1024}; pg8::StaticOrder S; S.init(MROWS, 1024, G, bid);
          float* XB = WSP(float, WS_X);
          pg8::EpiResid E{l == 0 ? a.x_prompt() : XB, l == 0 ? a.x_sample() : XB + (size_t)MP * 1024, WSP(float, WS_MOD) + (size_t)l * NCOND * 3072 + 2048, XB};
          pg8::gemm_phase<pg8::EpiResid, pg8::StaticOrder, true, true>(lds, g, S, E); }
        grid.sync();
        norm_phase(a, l + 1, WSP(float, WS_X), TID(), bid, G);
        if (l == 0) grid.sync();
    }
}

extern "C" void kernel_launch(void* const* d_in, const int* in_sizes, int n_in, void* d_out, int out_size, void* d_ws, size_t ws_size, hipStream_t stream) {
    static int grid = 0;
    if (grid == 0) {
        if (n_in != 19 || (size_t)out_size != O_TOTAL || ws_size < WS_END) { fprintf(stderr, "kernel_launch: unexpected sizes: n_in %d out %d (want %zu) ws %zu (want >= %zu)\n", n_in, out_size, (size_t)O_TOTAL, ws_size, (size_t)WS_END); grid = -1; return; }
        int dev = 0, cus = 0, per_cu = 0;
        hipGetDevice(&dev); hipDeviceGetAttribute(&cus, hipDeviceAttributeMultiprocessorCount, dev);
        if (hipFuncSetAttribute((const void*)hybrid_step_fwd, hipFuncAttributeMaxDynamicSharedMemorySize, LDS_BYTES) != hipSuccess) { fprintf(stderr, "kernel_launch: hipFuncSetAttribute failed\n"); grid = -1; return; }
        if (hipOccupancyMaxActiveBlocksPerMultiprocessor(&per_cu, (const void*)hybrid_step_fwd, NTHREADS, LDS_BYTES) != hipSuccess || per_cu < 1) { fprintf(stderr, "kernel_launch: occupancy query failed (%d)\n", per_cu); (void)hipGetLastError(); grid = -1; return; }
        grid = cus * per_cu;
        fprintf(stderr, "kernel_launch: %d CUs x %d blocks/CU -> grid %d\n", cus, per_cu, grid);
    }
    if (grid < 0) return;
    Args a{};
    a.x_prompt = (const float*)d_in[0]; a.x_sample = (const float*)d_in[1]; a.cache0 = (const float*)d_in[2]; a.cache1 = (const float*)d_in[3]; a.cache2 = (const float*)d_in[4];
    a.c_prompt = (const float*)d_in[5]; a.c_sample = (const float*)d_in[6]; a.w_ada = (const float*)d_in[7]; a.b_ada = (const float*)d_in[8]; a.norm_g = (const float*)d_in[9];
    a.w_in = (const float*)d_in[10]; a.gm_ln_g = (const float*)d_in[11]; a.gm_ln_b = (const float*)d_in[12]; a.gm_ws = (const float*)d_in[13]; a.gm_bs = (const float*)d_in[14];
    a.w_gm_out = (const float*)d_in[15]; a.w_att_out = (const float*)d_in[16]; a.w_o = (const float*)d_in[17]; a.final_g = (const float*)d_in[18];
    a.out = (float*)d_out; a.ws = (unsigned char*)d_ws;
    void* args[] = {&a};
    hipError_t e = hipLaunchCooperativeKernel((const void*)hybrid_step_fwd, dim3(grid), dim3(NTHREADS), args, LDS_BYTES, stream);
    if (e != hipSuccess) fprintf(stderr, "kernel_launch: cooperative launch failed: %s (grid %d)\n", hipGetErrorString(e), grid);
}
```

```cpp
#include <hip/hip_runtime.h>
#include <hip/hip_cooperative_groups.h>
#include <cstdio>
#include <cstdint>
#include <cmath>
namespace cg = cooperative_groups;

constexpr int D = 1024, SEQ = 2048, NBATCH = 16, MP = NBATCH * SEQ, DBATCH = 32, TDEC = 8, MS = DBATCH * TDEC, MROWS = MP + MS;
constexpr int NPROJ = 10240, NCOND = 48, PAST = 16384;
constexpr int C_U = 0, C_V = 1024, C_ZA = 2048, C_Q = 3072, C_K = 4608, C_VAL = 6144, C_ZB = 7680, C_GA = 8192, C_GB = 9216;
constexpr size_t O_Y = 0, O_KVP0 = (size_t)MROWS * 1024, O_KVP1 = O_KVP0 + 4194304, O_KVP2 = O_KVP1 + 16777216, O_KVS0 = O_KVP2 + 67108864,
                 O_KVS1 = O_KVS0 + 524288, O_KVS2 = O_KVS1 + 524288, O_GMV = O_KVS2 + 524288, O_TOTAL = O_GMV + 524288;

typedef unsigned short bf16;
typedef float f32x4 __attribute__((ext_vector_type(4)));
typedef float f32x2 __attribute__((ext_vector_type(2)));
typedef unsigned u32x4 __attribute__((ext_vector_type(4)));
typedef unsigned u32x2 __attribute__((ext_vector_type(2)));
#define LAS __attribute__((address_space(3)))

__device__ __forceinline__ float sigmoidf_(float z) { return __builtin_amdgcn_rcpf(1.0f + __builtin_amdgcn_exp2f(-1.4426950408889634f * z)); }
__device__ __forceinline__ float siluf_(float z) { return z * sigmoidf_(z); }
__device__ __forceinline__ float geluf_(float x) { return x * sigmoidf_(1.5957691216057308f * (x + 0.044715f * x * x * x)); }
__device__ __forceinline__ unsigned f2bf(float f) { unsigned u = __builtin_bit_cast(unsigned, f); return (u + 0x7fffu + ((u >> 16) & 1u)) >> 16; }
__device__ __forceinline__ unsigned pk2(float lo, float hi) { return f2bf(lo) | (f2bf(hi) << 16); }
__device__ __forceinline__ float bflo(unsigned w) { return __builtin_bit_cast(float, w << 16); }
__device__ __forceinline__ float bfhi(unsigned w) { return __builtin_bit_cast(float, w & 0xffff0000u); }
__device__ __forceinline__ float bf2f(bf16 b) { return __builtin_bit_cast(float, (unsigned)b << 16); }
__device__ __forceinline__ int cond_row(int m) { return m < MP ? (m >> 11) : NBATCH + ((m - MP) >> 3); }

__device__ __forceinline__ float* kv_out_ptr(float* out_, int l, int m, int g, int kvsel) {
    if (m >= MP) { const int r = m - MP; const size_t off = (g == 0 ? O_KVS0 : g == 1 ? O_KVS1 : O_KVS2); return out_ + off + (((size_t)l * MS + r) * 2 + kvsel) * 512; }
    const int b = m >> 11, t = m & 2047; const int nk = g == 0 ? 128 : g == 1 ? 512 : 2048; const int i = t - (SEQ - nk); if (i < 0) return nullptr;
    const size_t off = (g == 0 ? O_KVP0 : g == 1 ? O_KVP1 : O_KVP2); return out_ + off + ((((size_t)l * NBATCH + b) * nk + i) * 2 + kvsel) * 512;
}
constexpr size_t QKV_S_OFF = (size_t)NBATCH * 24 * 2048 * 64;
__device__ __forceinline__ size_t qkv_off(int row, int head) {
    if (row >= MP) return QKV_S_OFF + (size_t)(row - MP) * 1536 + head * 64;
    const int b = row >> 11, t = row & 2047, sh = 2 * (head >> 3); return ((size_t)(b * 24 + head) * 2048 + (size_t)(t & ((1 << sh) - 1)) * (2048 >> sh) + (t >> sh)) * 64;
}
constexpr size_t MiB = 1u << 20;
constexpr size_t WS_MOD = 1 * MiB, WS_ROPE = 3 * MiB, WS_WTIN = 4 * MiB, WS_WTCAT = 44 * MiB  , WS_WTO = 50 * MiB, WS_WMB = 55 * MiB,
                 WS_H = 56 * MiB, WS_Y = 122 * MiB  , WS_OG = 222 * MiB, WS_LSE = 320 * MiB, WS_MERGED = 324 * MiB,
                 WS_X = 520 * MiB,
                 WS_UZ = 650 * MiB, WS_GV = 715 * MiB, WS_Q = 780 * MiB, WS_K = 877 * MiB, WS_V = 974 * MiB, WS_ZB = 1071 * MiB, WS_SGA = 1104 * MiB, WS_SGB = 1169 * MiB, WS_END = 1234 * MiB;
__host__ __device__ __forceinline__ int proj_src_col32(int nb) {
    const int pn = nb >> 3, wb = nb & 7, bj = wb >> 2, q4 = wb & 3;
    if (pn < 8) return (bj ? C_ZA : C_U) + 128 * pn + 32 * q4;
    if (pn < 12) return C_V + 256 * (pn - 8) + 32 * wb;
    if (pn < 18) return C_Q + (4 * (pn - 12) + q4) * 64 + 32 * bj;
    if (pn < 24) return C_K + (4 * (pn - 18) + q4) * 64 + 32 * bj;
    if (pn < 30) return C_VAL + 256 * (pn - 24) + 32 * wb;
    if (pn < 32) return C_ZB + 256 * (pn - 30) + 32 * wb;
    if (pn < 36) return C_GA + 256 * (pn - 32) + 32 * wb;
    return C_GB + 256 * (pn - 36) + 32 * wb;
}

namespace pg8 {
#define PG8_LAS __attribute__((address_space(3)))
typedef unsigned short bf16_t;
typedef short bf16x8 __attribute__((ext_vector_type(8)));
typedef float f32x4 __attribute__((ext_vector_type(4)));
typedef unsigned u32x4 __attribute__((ext_vector_type(4)));
constexpr int BM = 256, BK = 64, HALF = 128, HTB = HALF * BK * 2  , STAGE_BYTES = 8 * HTB, NXCD = 8, WGM = 8;

__host__ __device__ __forceinline__ int lds_byte(int r, int c) { const int st = (r >> 4) * 2 + (c >> 5), rr = r & 15, cc = c & 31, ob = rr * 64 + cc * 2; return st * 1024 + (ob ^ (((ob >> 9) & 1) << 5)); }
__host__ __device__ __forceinline__ void stage_rc(int b, int& R, int& C) { const int st = b / 1024, sb = b % 1024, swz = sb ^ (((sb >> 9) & 1) << 5); R = (st >> 1) * 16 + swz / 64; C = (st & 1) * 32 + (swz % 64) / 2; }
__host__ __device__ __forceinline__ int perm32(int rho) { const int n = rho >> 4, i = rho & 15; return 8 * (i >> 2) + 4 * n + (i & 3); }

struct Unit { int pm, pn; };
struct Gemm { const bf16_t* A; const bf16_t* Bt; int M, N, K; };

struct StaticOrder {
    int nM, nN, nwg, G, c;
    __host__ __device__ void init(int M, int N, int G_, int c_) { nM = M / BM; nN = N / BM; nwg = nM * nN; G = G_; c = c_; }
    __host__ __device__ bool next(int i, Unit& u) const {
        const long L = (long)i * G + c; if (L >= nwg) return false;
        int wgid = (int)L; { const int q = nwg / NXCD, r = nwg % NXCD, xcd = wgid % NXCD, off = wgid / NXCD; wgid = (xcd < r ? xcd * (q + 1) : r * (q + 1) + (xcd - r) * q) + off; }
        const int nig = WGM * nN, gid = wgid / nig, fm = gid * WGM, gsz = (nM - fm) < WGM ? (nM - fm) : WGM;
        u.pm = fm + ((wgid % nig) % gsz); u.pn = (wgid % nig) / gsz; return true;
    }
    __device__ __forceinline__ void a_ready(const Unit&) const {}
    __device__ __forceinline__ void done(const Unit&) const {}
};

__device__ __forceinline__ unsigned cvt_pk_bf16(float lo, float hi) { unsigned r; asm volatile("v_cvt_pk_bf16_f32 %0, %1, %2" : "=v"(r) : "v"(lo), "v"(hi)); return r; }
typedef float f32x2 __attribute__((ext_vector_type(2)));
__device__ __forceinline__ u32x4 pack8(const f32x4 a, const f32x4 b) { u32x4 w; w.x = cvt_pk_bf16(a[0], a[1]); w.y = cvt_pk_bf16(a[2], a[3]); w.z = cvt_pk_bf16(b[0], b[1]); w.w = cvt_pk_bf16(b[2], b[3]); return w; }
struct EpiProj {
    static constexpr bool PERM = true, AFTER_DRAIN = false;
    unsigned char* ws; float* out; int l;
    __device__ __forceinline__ void operator()(const f32x4 (&acc)[2][2][4][2], const Unit& u, int wr, int wc, int fr, int fq) const {
        const int pn = u.pn, row0 = u.pm * BM + wr * 64 + fr;
        if (pn < 8) {
            bf16_t* O = (bf16_t*)(ws + ::WS_UZ) + 128 * pn + 32 * wc + 8 * fq;
#pragma unroll
            for (int ai = 0; ai < 2; ++ai)
#pragma unroll
                for (int m = 0; m < 4; ++m) { f32x4 r0, r1;
#pragma unroll
                    for (int j = 0; j < 4; ++j) { r0[j] = ::geluf_(acc[ai][0][m][0][j]) * ::siluf_(acc[ai][1][m][0][j]); r1[j] = ::geluf_(acc[ai][0][m][1][j]) * ::siluf_(acc[ai][1][m][1][j]); }
                    *(u32x4*)(O + (size_t)(row0 + ai * HALF + m * 16) * 1024) = pack8(r0, r1); }
        } else if (pn < 12 || pn >= 30) {
            const int kind = pn < 12 ? 0 : pn < 32 ? 1 : 2;
            bf16_t* O; int ld;
            if (pn < 12) { O = (bf16_t*)(ws + ::WS_GV) + 256 * (pn - 8); ld = 1024; } else if (pn < 32) { O = (bf16_t*)(ws + ::WS_ZB) + 256 * (pn - 30); ld = 512; }
            else if (pn < 36) { O = (bf16_t*)(ws + ::WS_SGA) + 256 * (pn - 32); ld = 1024; } else { O = (bf16_t*)(ws + ::WS_SGB) + 256 * (pn - 36); ld = 1024; }
            O += 32 * wc + 8 * fq;
#pragma unroll
            for (int ai = 0; ai < 2; ++ai)
#pragma unroll
                for (int m = 0; m < 4; ++m)
#pragma unroll
                    for (int bj = 0; bj < 2; ++bj) { f32x4 r0, r1;
#pragma unroll
                        for (int j = 0; j < 4; ++j) { const float x0 = acc[ai][bj][m][0][j], x1 = acc[ai][bj][m][1][j];
                            r0[j] = kind == 0 ? ::geluf_(x0) : kind == 1 ? ::siluf_(x0) : ::sigmoidf_(x0); r1[j] = kind == 0 ? ::geluf_(x1) : kind == 1 ? ::siluf_(x1) : ::sigmoidf_(x1); }
                        *(u32x4*)(O + (size_t)(row0 + ai * HALF + m * 16) * ld + bj * HALF) = pack8(r0, r1); }
        } else if (pn < 24) {
            const bool isk = pn >= 18; const int head = 4 * (isk ? pn - 18 : pn - 12) + wc;
            bf16_t* O = (bf16_t*)(ws + (isk ? ::WS_K : ::WS_Q)) + 8 * fq;
            const f32x2* rt = (const f32x2*)(ws + ::WS_ROPE);
#pragma unroll
            for (int ai = 0; ai < 2; ++ai)
#pragma unroll
                for (int m = 0; m < 4; ++m) { const int row = row0 + ai * HALF + m * 16; const int pi = row < ::MP ? (row & 2047) : ::SEQ + ((row - ::MP) & 7);
                    const f32x4* cp = (const f32x4*)(rt + pi * 32 + 8 * fq); const f32x4 cs0 = cp[0], cs1 = cp[1], cs2 = cp[2], cs3 = cp[3];
                    const f32x4 xa = acc[ai][0][m][0], xb = acc[ai][0][m][1], ya = acc[ai][1][m][0], yb = acc[ai][1][m][1];
                    f32x4 o1a, o1b, o2a, o2b;
                    o1a[0] = xa[0] * cs0[0] - ya[0] * cs0[1]; o2a[0] = ya[0] * cs0[0] + xa[0] * cs0[1]; o1a[1] = xa[1] * cs0[2] - ya[1] * cs0[3]; o2a[1] = ya[1] * cs0[2] + xa[1] * cs0[3];
                    o1a[2] = xa[2] * cs1[0] - ya[2] * cs1[1]; o2a[2] = ya[2] * cs1[0] + xa[2] * cs1[1]; o1a[3] = xa[3] * cs1[2] - ya[3] * cs1[3]; o2a[3] = ya[3] * cs1[2] + xa[3] * cs1[3];
                    o1b[0] = xb[0] * cs2[0] - yb[0] * cs2[1]; o2b[0] = yb[0] * cs2[0] + xb[0] * cs2[1]; o1b[1] = xb[1] * cs2[2] - yb[1] * cs2[3]; o2b[1] = yb[1] * cs2[2] + xb[1] * cs2[3];
                    o1b[2] = xb[2] * cs3[0] - yb[2] * cs3[1]; o2b[2] = yb[2] * cs3[0] + xb[2] * cs3[1]; o1b[3] = xb[3] * cs3[2] - yb[3] * cs3[3]; o2b[3] = yb[3] * cs3[2] + xb[3] * cs3[3];
                    bf16_t* op = O + ::qkv_off(row, head); *(u32x4*)op = pack8(o1a, o1b); *(u32x4*)(op + 32) = pack8(o2a, o2b);
                    if (isk) { float* ko = ::kv_out_ptr(out, l, row, head >> 3, 0); if (ko) { ko += (head & 7) * 64 + 8 * fq; *(f32x4*)ko = o1a; *(f32x4*)(ko + 4) = o1b; *(f32x4*)(ko + 32) = o2a; *(f32x4*)(ko + 36) = o2b; } } }
        } else {
            bf16_t* O = (bf16_t*)(ws + ::WS_V);
#pragma unroll
            for (int ai = 0; ai < 2; ++ai)
#pragma unroll
                for (int m = 0; m < 4; ++m) { const int row = row0 + ai * HALF + m * 16;
#pragma unroll
                    for (int bj = 0; bj < 2; ++bj) { const int col = 256 * (pn - 24) + bj * HALF + 32 * wc + 8 * fq;
                        *(u32x4*)(O + ::qkv_off(row, col >> 6) + (col & 63)) = pack8(acc[ai][bj][m][0], acc[ai][bj][m][1]);
                        float* vo = ::kv_out_ptr(out, l, row, col >> 9, 1); if (vo) { vo += col & 511; *(f32x4*)vo = acc[ai][bj][m][0]; *(f32x4*)(vo + 4) = acc[ai][bj][m][1]; } } }
        }
    }
};
struct EpiMerge {
    static constexpr bool PERM = true, AFTER_DRAIN = false;
    const bf16_t* SGA; const bf16_t* SGB; bf16_t* O;
    __device__ __forceinline__ void mid(f32x4 (&acc)[2][2][4][2], const Unit& u, int wr, int wc, int fr, int fq) const {
        unsigned voff = (unsigned)(((wr * 64 + fr) * 1024 + wc * 32 + 8 * fq) * 2); asm volatile("" : "+v"(voff));
        const size_t tb = ((size_t)u.pm * BM * 1024 + (size_t)u.pn * BM) * 2;
        const char* pa = (const char*)SGA + tb; const char* pb = (const char*)SGB + tb;
#pragma unroll
        for (int ai = 0; ai < 2; ++ai)
#pragma unroll
            for (int m = 0; m < 4; ++m)
#pragma unroll
                for (int bj = 0; bj < 2; ++bj) { const int cb = ((ai * HALF + m * 16) * 1024 + bj * HALF) * 2; const u32x4 ga = *(const u32x4*)(pa + cb + voff), gb = *(const u32x4*)(pb + cb + voff);
                    f32x4 r0, r1; r0[0] = ::bflo(ga.x) * __builtin_amdgcn_rcpf(::bflo(gb.x)); r0[1] = ::bfhi(ga.x) * __builtin_amdgcn_rcpf(::bfhi(gb.x)); r0[2] = ::bflo(ga.y) * __builtin_amdgcn_rcpf(::bflo(gb.y)); r0[3] = ::bfhi(ga.y) * __builtin_amdgcn_rcpf(::bfhi(gb.y));
                    r1[0] = ::bflo(ga.z) * __builtin_amdgcn_rcpf(::bflo(gb.z)); r1[1] = ::bfhi(ga.z) * __builtin_amdgcn_rcpf(::bfhi(gb.z)); r1[2] = ::bflo(ga.w) * __builtin_amdgcn_rcpf(::bflo(gb.w)); r1[3] = ::bfhi(ga.w) * __builtin_amdgcn_rcpf(::bfhi(gb.w));
                    acc[ai][bj][m][0] *= r0; acc[ai][bj][m][1] *= r1; if (bj == 1) asm volatile("" ::: "memory"); }
    }
    __device__ __forceinline__ void operator()(const f32x4 (&acc)[2][2][4][2], const Unit& u, int wr, int wc, int fr, int fq) const {
        unsigned voff = (unsigned)(((wr * 64 + fr) * 1024 + wc * 32 + 8 * fq) * 2); asm volatile("" : "+v"(voff));
        const size_t tb = ((size_t)u.pm * BM * 1024 + (size_t)u.pn * BM) * 2;
        const char* pb = (const char*)SGB + tb; char* po = (char*)O + tb;
#pragma unroll
        for (int ai = 0; ai < 2; ++ai)
#pragma unroll
            for (int m = 0; m < 4; ++m)
#pragma unroll
                for (int bj = 0; bj < 2; ++bj) { const int cb = ((ai * HALF + m * 16) * 1024 + bj * HALF) * 2; const u32x4 gb = *(const u32x4*)(pb + cb + voff);
                    f32x4 r0, r1; r0[0] = ::bflo(gb.x); r0[1] = ::bfhi(gb.x); r0[2] = ::bflo(gb.y); r0[3] = ::bfhi(gb.y); r1[0] = ::bflo(gb.z); r1[1] = ::bfhi(gb.z); r1[2] = ::bflo(gb.w); r1[3] = ::bfhi(gb.w);
                    *(u32x4*)(po + cb + voff) = pack8(acc[ai][bj][m][0] * r0, acc[ai][bj][m][1] * r1); }
    }
};
struct EpiResid {
    static constexpr bool PERM = false, AFTER_DRAIN = false;
    const float* xp; const float* xs; const float* gate  ; float* xo;
    __device__ __forceinline__ void operator()(const f32x4 (&acc)[2][2][4][2], const Unit& u, int wr, int wc, int fr, int fq) const {
        const int row0 = u.pm * BM + wr * 64 + fr, col0 = u.pn * BM + wc * 32 + 4 * fq;
#pragma unroll
        for (int ai = 0; ai < 2; ++ai)
#pragma unroll
            for (int m = 0; m < 4; ++m) { const int r = row0 + ai * HALF + m * 16; const float* xr = r < ::MP ? xp + (size_t)r * 1024 : xs + (size_t)(r - ::MP) * 1024;
                const float* gr = gate + (size_t)::cond_row(r) * 3072;
#pragma unroll
                for (int bj = 0; bj < 2; ++bj)
#pragma unroll
                    for (int n = 0; n < 2; ++n) { const int c = col0 + bj * HALF + n * 16; const f32x4 xv = *(const f32x4*)(xr + c), gv = *(const f32x4*)(gr + c);
                        *(f32x4*)(xo + (size_t)r * 1024 + c) = xv + gv * acc[ai][bj][m][n]; } }
    }
};
template <class Epi, class Sched, bool ALIGN_EPI = false, bool SP2 = false, int MID = -1  >
__device__ __forceinline__ void gemm_phase(PG8_LAS unsigned char* lds, const Gemm g, const Sched& S, const Epi& E) {
    int tid_ = threadIdx.x; asm volatile("" : "+v"(tid_));
    const int tid = tid_, wid = __builtin_amdgcn_readfirstlane(tid >> 6), lane = tid & 63, wr = wid >> 2, wc = wid & 3, fr = lane & 15, fq = lane >> 4;
    const int K = g.K, nt = K / BK;
    unsigned voffA[2], voffB[2];
#pragma unroll
    for (int i = 0; i < 2; ++i) { int R, C; stage_rc(tid * 16 + i * 8192, R, C); const int Rb = Epi::PERM ? ((R & ~31) + perm32(R & 31)) : R;
        voffA[i] = (unsigned)(R * K + C) * 2u; voffB[i] = (unsigned)(Rb * K + C) * 2u; }
    const size_t kstep = (size_t)(BK * 2);
    const size_t hstep = (size_t)HALF * K * 2;
    const size_t tstep = 2 * hstep;
    const unsigned ldsw = (unsigned)wid * 1024u;
    const int aoff = lds_byte(wr * 64 + fr, fq * 8), boff = lds_byte(wc * 32 + fr, fq * 8);
#define PG8_SA(b, h) (((b) * 2 + (h)) * HTB)
#define PG8_SB(b, h) ((4 + (b) * 2 + (h)) * HTB)
#define PG8_STAGE(bufoff, gbase, voff) do { _Pragma("unroll") for (int _i = 0; _i < 2; ++_i) \
        __builtin_amdgcn_global_load_lds((const unsigned*)((const char*)(gbase) + (voff)[_i]), (PG8_LAS unsigned*)(lds + (bufoff) + ldsw + _i * 8192), 16, 0, 0); } while (0)
#define PG8_LDA(dst, b, h) do { _Pragma("unroll") for (int m = 0; m < 4; ++m) _Pragma("unroll") for (int k = 0; k < 2; ++k) dst[m][k] = *(const PG8_LAS bf16x8*)(lds + PG8_SA(b, h) + aoff + m * 2048 + k * 1024); } while (0)
#define PG8_LDB(dst, b, h) do { _Pragma("unroll") for (int n = 0; n < 2; ++n) _Pragma("unroll") for (int k = 0; k < 2; ++k) dst[n][k] = *(const PG8_LAS bf16x8*)(lds + PG8_SB(b, h) + boff + n * 2048 + k * 1024); } while (0)
#define PG8_MMA(ai, bj, At, Bt) do { __builtin_amdgcn_s_setprio(1); _Pragma("unroll") for (int m = 0; m < 4; ++m) _Pragma("unroll") for (int n = 0; n < 2; ++n) _Pragma("unroll") for (int k = 0; k < 2; ++k) \
        acc[ai][bj][m][n] = __builtin_amdgcn_mfma_f32_16x16x32_bf16(Bt[n][k], At[m][k], acc[ai][bj][m][n], 0, 0, 0); __builtin_amdgcn_s_setprio(0); } while (0)
#define PG8_WAIT_V(n) asm volatile("s_waitcnt vmcnt(" #n ")" ::: "memory")
#define PG8_WAIT_L(n) asm volatile("s_waitcnt lgkmcnt(" #n ")" ::: "memory")
#define PG8_BAR __builtin_amdgcn_s_barrier()
#define PG8_SCHED __builtin_amdgcn_sched_barrier(0)
    Unit cur, nxt; int ui = 0;
    if (!S.next(0, cur)) return;
    f32x4 acc[2][2][4][2];
#pragma unroll
    for (int a = 0; a < 2; ++a)
#pragma unroll
        for (int b = 0; b < 2; ++b)
#pragma unroll
            for (int m = 0; m < 4; ++m)
#pragma unroll
                for (int n = 0; n < 2; ++n) acc[a][b][m][n] = (f32x4){0.f, 0.f, 0.f, 0.f};
    bf16x8 At[4][2], B0[2][2], B1[2][2];
    const char* cA = (const char*)g.A + (size_t)cur.pm * tstep; const char* cB = (const char*)g.Bt + (size_t)cur.pn * tstep;
    S.a_ready(cur);
    if constexpr (SP2) {
        PG8_STAGE(PG8_SB(0, 0), cB, voffB); PG8_STAGE(PG8_SB(0, 1), cB + hstep, voffB); PG8_STAGE(PG8_SA(0, 0), cA, voffA); PG8_STAGE(PG8_SA(0, 1), cA + hstep, voffA);
        if (wr == 1) PG8_BAR;
        PG8_WAIT_V(2); PG8_BAR;
        PG8_STAGE(PG8_SB(1, 0), cB + kstep, voffB); PG8_STAGE(PG8_SA(1, 0), cA + kstep, voffA); PG8_STAGE(PG8_SB(1, 1), cB + hstep + kstep, voffB);
        PG8_WAIT_V(6); PG8_BAR;
    } else {
        PG8_STAGE(PG8_SB(0, 0), cB, voffB); PG8_STAGE(PG8_SA(0, 0), cA, voffA); PG8_STAGE(PG8_SB(0, 1), cB + hstep, voffB); PG8_STAGE(PG8_SA(0, 1), cA + hstep, voffA);
        if (wr == 1) PG8_BAR;
        PG8_WAIT_V(4); PG8_BAR;
        PG8_STAGE(PG8_SB(1, 0), cB + kstep, voffB); PG8_STAGE(PG8_SA(1, 0), cA + kstep, voffA); PG8_STAGE(PG8_SB(1, 1), cB + hstep + kstep, voffB);
        PG8_WAIT_V(6); PG8_BAR;
    }
    for (;;) {
        const bool has_next = S.next(ui + 1, nxt);
        const char* nA = has_next ? (const char*)g.A + (size_t)nxt.pm * tstep : cA; const char* nB = has_next ? (const char*)g.Bt + (size_t)nxt.pn * tstep : cB;
        for (int t = 0; t < nt; t += 2) {
            const bool last = (t == nt - 2);
            if constexpr (MID >= 0) { if (t == MID) E.mid(acc, cur, wr, wc, fr, fq); asm volatile("" ::: "memory"); PG8_SCHED; }
            const char* a1 = cA + (size_t)(t + 1) * kstep;
            const char* a2 = last ? nA : cA + (size_t)(t + 2) * kstep; const char* b2 = last ? nB : cB + (size_t)(t + 2) * kstep;
            const char* a3 = a2 + kstep; const char* b3 = b2 + kstep;
            if (last && has_next) S.a_ready(nxt);
            if constexpr (SP2) {
            PG8_LDB(B0, 0, 0); PG8_LDB(B1, 0, 1); PG8_SCHED; PG8_LDA(At, 0, 0); PG8_STAGE(PG8_SA(1, 1), a1 + hstep, voffA);
            PG8_WAIT_V(8); PG8_WAIT_L(0); PG8_BAR; PG8_MMA(0, 0, At, B0); PG8_MMA(0, 1, At, B1); PG8_BAR; PG8_SCHED;
            PG8_LDA(At, 0, 1); PG8_STAGE(PG8_SB(0, 0), b2, voffB); PG8_STAGE(PG8_SB(0, 1), b2 + hstep, voffB); PG8_STAGE(PG8_SA(0, 0), a2, voffA);
            PG8_WAIT_V(8); PG8_WAIT_L(0); PG8_BAR; PG8_MMA(1, 0, At, B0); PG8_MMA(1, 1, At, B1); PG8_BAR; PG8_SCHED;
            PG8_LDB(B0, 1, 0); PG8_LDB(B1, 1, 1); PG8_SCHED; PG8_LDA(At, 1, 0); PG8_STAGE(PG8_SA(0, 1), a2 + hstep, voffA);
            PG8_WAIT_V(8); PG8_WAIT_L(0); PG8_BAR; PG8_MMA(0, 0, At, B0); PG8_MMA(0, 1, At, B1); PG8_BAR; PG8_SCHED;
            PG8_LDA(At, 1, 1); PG8_STAGE(PG8_SB(1, 0), b3, voffB); PG8_STAGE(PG8_SB(1, 1), b3 + hstep, voffB); PG8_STAGE(PG8_SA(1, 0), a3, voffA);
            PG8_WAIT_V(8); PG8_WAIT_L(0); PG8_BAR; PG8_MMA(1, 0, At, B0); PG8_MMA(1, 1, At, B1); PG8_BAR; PG8_SCHED;
            } else {
            PG8_LDB(B0, 0, 0); PG8_SCHED; PG8_LDA(At, 0, 0); PG8_STAGE(PG8_SA(1, 1), a1 + hstep, voffA);
            PG8_WAIT_L(8); PG8_BAR; PG8_WAIT_L(0); PG8_MMA(0, 0, At, B0); PG8_BAR; PG8_SCHED;
            PG8_LDB(B1, 0, 1); PG8_STAGE(PG8_SB(0, 0), b2, voffB);
            PG8_BAR; PG8_WAIT_L(0); PG8_MMA(0, 1, At, B1); PG8_BAR;
            PG8_LDA(At, 0, 1); PG8_STAGE(PG8_SA(0, 0), a2, voffA);
            PG8_BAR; PG8_WAIT_L(0); PG8_MMA(1, 0, At, B0); PG8_BAR; PG8_SCHED;
            PG8_STAGE(PG8_SB(0, 1), b2 + hstep, voffB);
            PG8_WAIT_V(6); PG8_BAR; PG8_MMA(1, 1, At, B1); PG8_BAR;
            PG8_LDB(B0, 1, 0); PG8_SCHED; PG8_LDA(At, 1, 0); PG8_STAGE(PG8_SA(0, 1), a2 + hstep, voffA);
            PG8_WAIT_L(8); PG8_BAR; PG8_WAIT_L(0); PG8_MMA(0, 0, At, B0); PG8_BAR; PG8_SCHED;
            PG8_LDB(B1, 1, 1); PG8_STAGE(PG8_SB(1, 0), b3, voffB);
            PG8_BAR; PG8_WAIT_L(0); PG8_MMA(0, 1, At, B1); PG8_BAR;
            PG8_LDA(At, 1, 1); PG8_STAGE(PG8_SA(1, 0), a3, voffA);
            PG8_BAR; PG8_WAIT_L(0); PG8_MMA(1, 0, At, B0); PG8_BAR; PG8_SCHED;
            PG8_STAGE(PG8_SB(1, 1), b3 + hstep, voffB);
            PG8_WAIT_V(6); PG8_BAR; PG8_MMA(1, 1, At, B1); PG8_BAR;
            }
        }
        if constexpr (ALIGN_EPI) { if (wr == 0) PG8_BAR; }
        if constexpr (!Epi::AFTER_DRAIN) { E(acc, cur, wr, wc, fr, fq); S.done(cur); }
        if (!has_next) break;
#pragma unroll
        for (int a = 0; a < 2; ++a)
#pragma unroll
            for (int b = 0; b < 2; ++b)
#pragma unroll
                for (int m = 0; m < 4; ++m)
#pragma unroll
                    for (int n = 0; n < 2; ++n) acc[a][b][m][n] = (f32x4){0.f, 0.f, 0.f, 0.f};
        cur = nxt; cA = nA; cB = nB; ++ui;
        if constexpr (ALIGN_EPI) { if (wr == 1) PG8_BAR; }
    }
    PG8_WAIT_V(0);
    if constexpr (!ALIGN_EPI) { if (wr == 0) PG8_BAR; }
    PG8_BAR;
    if constexpr (Epi::AFTER_DRAIN) { E.fused(acc, cur, wr, wc, fr, fq, lds, wid, lane); S.done(cur); }
#undef PG8_SA
#undef PG8_SB
#undef PG8_STAGE
#undef PG8_LDA
#undef PG8_LDB
#undef PG8_MMA
#undef PG8_WAIT_V
#undef PG8_WAIT_L
#undef PG8_BAR
#undef PG8_SCHED
}
}
#ifndef PROBE_DUP
#define PROBE_DUP 0
#endif

constexpr size_t OG_STRIDE = (size_t)MROWS * 512;
constexpr size_t LSE_STRIDE = (size_t)MROWS * 8;
constexpr int LDS_BYTES = 147456;
constexpr int NTHREADS = 512;

struct Args {
    const float* x_prompt; const float* x_sample; const float* cache0; const float* cache1; const float* cache2; const float* c_prompt; const float* c_sample;
    const float* w_ada; const float* b_ada; const float* norm_g; const float* w_in; const float* gm_ln_g; const float* gm_ln_b; const float* gm_ws; const float* gm_bs;
    const float* w_gm_out; const float* w_att_out; const float* w_o; const float* final_g;
    float* out; unsigned char* ws;
};
constexpr int PTAB_OFF = 131072 + 1024;
struct PT {
    LAS const unsigned long long* t;
    __device__ __forceinline__ unsigned long long g(int i) const { const unsigned long long v = t[i]; const unsigned lo = __builtin_amdgcn_readfirstlane((unsigned)v), hi = __builtin_amdgcn_readfirstlane((unsigned)(v >> 32)); return ((unsigned long long)hi << 32) | lo; }
#define GASP(v) ((__attribute__((address_space(1))) unsigned char*)(v))
#define PTF(name, idx) __device__ __forceinline__ const float* name() const { return (const float*)GASP(g(idx)); }
    PTF(x_prompt, 0) PTF(x_sample, 1) PTF(cache0, 2) PTF(cache1, 3) PTF(cache2, 4) PTF(c_prompt, 5) PTF(c_sample, 6) PTF(w_ada, 7) PTF(b_ada, 8) PTF(norm_g, 9) PTF(w_in, 10)
    PTF(gm_ln_g, 11) PTF(gm_ln_b, 12) PTF(gm_ws, 13) PTF(gm_bs, 14) PTF(w_gm_out, 15) PTF(w_att_out, 16) PTF(w_o, 17) PTF(final_g, 18)
#undef PTF
    __device__ __forceinline__ float* out() const { return (float*)GASP(g(19)); }
    __device__ __forceinline__ unsigned char* ws() const { return (unsigned char*)GASP(g(20)); }
};
__device__ const float INV_FREQ[32] = {1.000000000e+00f, 7.498942614e-01f, 5.623413324e-01f, 4.216965139e-01f, 3.162277639e-01f, 2.371373773e-01f, 1.778279394e-01f, 1.333521307e-01f, 1.000000015e-01f, 7.498941571e-02f, 5.623413250e-02f, 4.216965288e-02f, 3.162277490e-02f, 2.371373773e-02f, 1.778279431e-02f, 1.333521493e-02f, 9.999999776e-03f, 7.498941850e-03f, 5.623413250e-03f, 4.216964822e-03f, 3.162277630e-03f, 2.371373586e-03f, 1.778279431e-03f, 1.333521446e-03f, 1.000000047e-03f, 7.498942432e-04f, 5.623413017e-04f, 4.216965172e-04f, 3.162277571e-04f, 2.371373703e-04f, 1.778279402e-04f, 1.333521504e-04f};

__device__ __forceinline__ float wave_sum(float v) {
#pragma unroll
    for (int o = 1; o < 64; o <<= 1) v += __shfl_xor(v, o);
    return v;
}

template <bool PROJ_ORDER> __device__ __forceinline__ void p0_transpose_item(const float* W, int K, int N, bf16* WT, int ldw  , LAS float* scr, int item, int lane) {
    const int nblk = N / 32, kb = item / nblk, nb = item % nblk, k0 = 64 * kb, n0 = 32 * nb, ns = PROJ_ORDER ? proj_src_col32(nb) : n0;
#pragma unroll 8
    for (int i = 0; i < 32; ++i) { const int kk = 2 * i + (lane >> 5); scr[kk * 33 + (lane & 31)] = W[(size_t)(k0 + kk) * N + ns + (lane & 31)]; }
    asm volatile("s_waitcnt lgkmcnt(0)" ::: "memory");
    const int c = lane & 7;
#pragma unroll
    for (int j = 0; j < 4; ++j) { const int n = (lane >> 3) + 8 * j; const LAS float* s = scr + (8 * c) * 33 + n;
        u32x4 o; o.x = pk2(s[0 * 33], s[1 * 33]); o.y = pk2(s[2 * 33], s[3 * 33]); o.z = pk2(s[4 * 33], s[5 * 33]); o.w = pk2(s[6 * 33], s[7 * 33]);
        *(u32x4*)(WT + (size_t)(n0 + n) * ldw + k0 + 8 * c) = o; }
    asm volatile("s_waitcnt lgkmcnt(0)" ::: "memory");
}

__device__ __forceinline__ void p0_mod_item(const PT& a, LAS unsigned char* lds, int item, int tid) {
    const float* c_prompt_ = a.c_prompt(); const float* c_sample_ = a.c_sample(); const float* w_ada_ = a.w_ada(); const float* b_ada_ = a.b_ada(); unsigned char* ws_ = a.ws();
    const int wave = tid >> 6, lane = tid & 63;
    const int rg = item % 3; const int r2 = item / 3; const int cb = r2 % 48; const int l = r2 / 48;
    const int row0 = rg * 16, col = cb * 64 + lane, k0 = wave * 128;
    LAS float* tab = (LAS float*)(lds + wave * 8192);
    for (int e = lane; e < 2048; e += 64) { const int rr = e >> 7, kk = e & 127; const int cr = row0 + rr;
        const float* cp = cr < NBATCH ? c_prompt_ + (size_t)cr * 1024 : c_sample_ + (size_t)(cr - NBATCH) * 1024; tab[e] = siluf_(cp[k0 + kk]); }
    asm volatile("s_waitcnt lgkmcnt(0)" ::: "memory");
    float acc[16];
#pragma unroll
    for (int r = 0; r < 16; ++r) acc[r] = 0.f;
    const float* wp = w_ada_ + (size_t)l * 1024 * 3072 + (size_t)k0 * 3072 + col;
#pragma unroll 2
    for (int kk = 0; kk < 128; kk += 4) {
        const float w0 = wp[(size_t)(kk + 0) * 3072], w1 = wp[(size_t)(kk + 1) * 3072], w2 = wp[(size_t)(kk + 2) * 3072], w3 = wp[(size_t)(kk + 3) * 3072];
#pragma unroll
        for (int r = 0; r < 16; ++r) { const f32x4 t = *(const LAS f32x4*)(tab + r * 128 + kk); acc[r] += (t[0] * w0 + t[1] * w1) + (t[2] * w2 + t[3] * w3); }
    }
    LAS float* red = (LAS float*)(lds + 65536);
#pragma unroll
    for (int r = 0; r < 16; ++r) red[(wave * 16 + r) * 64 + lane] = acc[r];
    __syncthreads();
    float* mod = (float*)(ws_ + WS_MOD);
    for (int e = tid; e < 1024; e += NTHREADS) { const int rr = e >> 6, cc = e & 63; float s = 0.f;
#pragma unroll
        for (int w = 0; w < 8; ++w) s += red[(w * 16 + rr) * 64 + cc];
        const int colg = cb * 64 + cc; mod[((size_t)l * NCOND + row0 + rr) * 3072 + colg] = s + b_ada_[l * 3072 + colg]; }
    __syncthreads();
}

__device__ __forceinline__ void p0_phase(const PT& a, LAS unsigned char* lds, int tid, int bid, int G) {
    const float* w_in_ = a.w_in(); const float* w_gm_out_ = a.w_gm_out(); const float* w_att_out_ = a.w_att_out(); const float* w_o_ = a.w_o(); unsigned char* ws_ = a.ws();
    const int wave = tid >> 6, lane = tid & 63;
    for (int it = bid; it < 288; it += G) p0_mod_item(a, lds, it, tid);
    { f32x2* rt = (f32x2*)(ws_ + WS_ROPE);
      for (int e = bid * NTHREADS + tid; e < 2056 * 32; e += G * NTHREADS) { const int pi = e >> 5, i = e & 31; const int pos = pi < SEQ ? pi : PAST + (pi - SEQ);
          const float ang = (float)pos * INV_FREQ[i]; const double rv = (double)ang * 0.15915494309189535; const float f = (float)(rv - rint(rv));
          f32x2 cs; cs.x = __builtin_amdgcn_cosf(f); cs.y = __builtin_amdgcn_sinf(f); rt[e] = cs; } }
    { const float* gm_ws_ = a.gm_ws(); bf16* wmb = (bf16*)(ws_ + WS_WMB);
      for (int e = bid * NTHREADS + tid; e < 2 * 8 * 16384; e += G * NTHREADS) { const int sidx = e & 127, tt = (e >> 7) & 127; wmb[e] = sidx <= tt ? (bf16)f2bf(gm_ws_[e]) : (bf16)0; } }
    LAS float* scr = (LAS float*)(lds + wave * 16384);
    const int gw = bid * 8 + wave, NGW = G * 8;
    constexpr int I_IN = 16 * 320, I_GM = 16 * 32, I_ATT = 8 * 32, I_O = 16 * 32, I_L = I_IN + I_GM + I_ATT + I_O;
    for (int it = gw; it < 2 * I_L; it += NGW) {
        const int l = it / I_L; int r = it % I_L;
        if (r < I_IN) { p0_transpose_item<true>(w_in_ + (size_t)l * 1024 * NPROJ, 1024, NPROJ, (bf16*)(ws_ + WS_WTIN) + (size_t)l * NPROJ * 1024, 1024, scr, r, lane); continue; } r -= I_IN;
        if (r < I_GM) { p0_transpose_item<false>(w_gm_out_ + (size_t)l * 1024 * 1024, 1024, 1024, (bf16*)(ws_ + WS_WTCAT) + (size_t)l * 1024 * 1536, 1536, scr, r, lane); continue; } r -= I_GM;
        if (r < I_ATT) { p0_transpose_item<false>(w_att_out_ + (size_t)l * 512 * 1024, 512, 1024, (bf16*)(ws_ + WS_WTCAT) + (size_t)l * 1024 * 1536 + 1024, 1536, scr, r, lane); continue; } r -= I_ATT;
        p0_transpose_item<false>(w_o_ + (size_t)l * 1024 * 1024, 1024, 1024, (bf16*)(ws_ + WS_WTO) + (size_t)l * 1024 * 1024, 1024, scr, r, lane);
    }
}

__device__ __forceinline__ void norm_phase(const PT& a, int l  , const float* xbuf  , int tid, int bid, int G) {
    const float* x_prompt_ = a.x_prompt(); const float* x_sample_ = a.x_sample(); const float* norm_g_ = a.norm_g(); const float* final_g_ = a.final_g(); float* out_ = a.out(); unsigned char* ws_ = a.ws();
    const int wave = tid >> 6, lane = tid & 63; const int gw = bid * 8 + wave, NGW = G * 8;
    const float* mod = (const float*)(ws_ + WS_MOD);
    bf16* H = (bf16*)(ws_ + WS_H);
    for (int m = gw; m < MROWS; m += NGW) {
        const float* xr = xbuf ? xbuf + (size_t)m * 1024 : (m < MP ? x_prompt_ + (size_t)m * 1024 : x_sample_ + (size_t)(m - MP) * 1024);
        f32x4 v[4]; float ss = 0.f;
#pragma unroll
        for (int j = 0; j < 4; ++j) { v[j] = *(const f32x4*)(xr + 4 * lane + 256 * j); ss += (v[j][0] * v[j][0] + v[j][1] * v[j][1]) + (v[j][2] * v[j][2] + v[j][3] * v[j][3]); }
        const float rstd = 1.0f / sqrtf(wave_sum(ss) * (1.0f / 1024.0f) + 1e-6f);
        if (l < 2) {
            const float* mr = mod + ((size_t)l * NCOND + cond_row(m)) * 3072;
#pragma unroll
            for (int j = 0; j < 4; ++j) { const int c = 4 * lane + 256 * j; const f32x4 g = *(const f32x4*)(norm_g_ + l * 1024 + c), sh = *(const f32x4*)(mr + c), sc = *(const f32x4*)(mr + 1024 + c);
                const f32x4 h = (v[j] * rstd) * g * (sc + 1.0f) + sh; u32x2 w; w.x = pk2(h[0], h[1]); w.y = pk2(h[2], h[3]); *(u32x2*)(H + (size_t)m * 1024 + c) = w; }
        } else {
#pragma unroll
            for (int j = 0; j < 4; ++j) { const int c = 4 * lane + 256 * j; const f32x4 g = *(const f32x4*)(final_g_ + c); *(f32x4*)(out_ + O_Y + (size_t)m * 1024 + c) = (v[j] * rstd) * g; }
        }
    }
}

typedef short bf16x8_t __attribute__((ext_vector_type(8)));
typedef float f32x16 __attribute__((ext_vector_type(16)));
typedef short s16x4_t __attribute__((ext_vector_type(4)));
__device__ __forceinline__ s16x4_t vtr(LAS const unsigned char* p) { return __builtin_bit_cast(s16x4_t, __builtin_amdgcn_ds_read_tr16_b64_v4i16((LAS s16x4_t*)p)); }
__device__ __forceinline__ void spatial_item(const PT& a, int l, int ci, LAS unsigned char* lds, int tid) {
    unsigned char* ws_ = a.ws(); const float* lng_ = a.gm_ln_g() + l * 1024; const float* lnb_ = a.gm_ln_b() + l * 1024; const float* bs_ = a.gm_bs() + (size_t)l * 1024; float* out_ = a.out();
    const int wave = __builtin_amdgcn_readfirstlane(tid >> 6), lane = tid & 63;
    const int m0 = ci < 256 ? ci * 128 : MP + (ci - 256) * 8, nrows = ci < 256 ? 128 : 8;
    const bf16* GV = (const bf16*)(ws_ + WS_GV); const bf16* UZ = (const bf16*)(ws_ + WS_UZ); bf16* YA = (bf16*)(ws_ + WS_Y);
    LAS f32x2* stat = (LAS f32x2*)(lds + 131072);
    { const int nper = nrows >> 3;
      for (int rr = 0; rr < nper; ++rr) { const int row = wave * nper + rr; const bf16* pr = GV + (size_t)(m0 + row) * 1024;
          float gv[16]; float sm = 0.f;
#pragma unroll
          for (int j = 0; j < 2; ++j) { const u32x4 w = *(const u32x4*)(pr + 8 * lane + 512 * j);
              gv[8 * j + 0] = bflo(w.x); gv[8 * j + 1] = bfhi(w.x); gv[8 * j + 2] = bflo(w.y); gv[8 * j + 3] = bfhi(w.y);
              gv[8 * j + 4] = bflo(w.z); gv[8 * j + 5] = bfhi(w.z); gv[8 * j + 6] = bflo(w.w); gv[8 * j + 7] = bfhi(w.w); }
#pragma unroll
          for (int i = 0; i < 16; ++i) sm += gv[i];
          const float mu = wave_sum(sm) * (1.0f / 1024.0f); float q = 0.f;
#pragma unroll
          for (int i = 0; i < 16; ++i) { const float dlt = gv[i] - mu; q += dlt * dlt; }
          const float rstd = 1.0f / sqrtf(wave_sum(q) * (1.0f / 1024.0f) + 1e-5f);
          if (lane == 0) stat[row] = (f32x2){mu, rstd};
          if (nrows == 8) {
#pragma unroll
              for (int j = 0; j < 2; ++j) { const int c = 8 * lane + 512 * j; float o[8];
#pragma unroll
                  for (int i = 0; i < 8; ++i) o[i] = (gv[8 * j + i] - mu) * rstd * lng_[c + i] + lnb_[c + i];
                  float* go = out_ + O_GMV + ((size_t)l * MS + (m0 - MP + row)) * 1024 + c; *(f32x4*)go = (f32x4){o[0], o[1], o[2], o[3]}; *(f32x4*)(go + 4) = (f32x4){o[4], o[5], o[6], o[7]}; } }
      } }
    __syncthreads();
    { const int g = wave, t32 = lane & 31, hi = lane >> 5; LAS unsigned char* img = lds + wave * 16384;
      const bf16* wmb = (const bf16*)(ws_ + WS_WMB) + ((size_t)l * 8 + g) * 16384;
      for (int hf = 0; hf < 2; ++hf) { const int col0 = g * 128 + hf * 64, c = lane & 7;
          float lg[8], lb[8];
#pragma unroll
          for (int i = 0; i < 8; ++i) { lg[i] = lng_[col0 + 8 * c + i]; lb[i] = lnb_[col0 + 8 * c + i]; }
#pragma unroll 4
          for (int i = 0; i < 16; ++i) { const int row = 8 * i + (lane >> 3); u32x4 w = (u32x4){0u, 0u, 0u, 0u};
              if (row < nrows) { const u32x4 x = *(const u32x4*)(GV + (size_t)(m0 + row) * 1024 + col0 + 8 * c); const f32x2 st = stat[row];
                  w.x = pk2((bflo(x.x) - st.x) * st.y * lg[0] + lb[0], (bfhi(x.x) - st.x) * st.y * lg[1] + lb[1]);
                  w.y = pk2((bflo(x.y) - st.x) * st.y * lg[2] + lb[2], (bfhi(x.y) - st.x) * st.y * lg[3] + lb[3]);
                  w.z = pk2((bflo(x.z) - st.x) * st.y * lg[4] + lb[4], (bfhi(x.z) - st.x) * st.y * lg[5] + lb[5]);
                  w.w = pk2((bflo(x.w) - st.x) * st.y * lg[6] + lb[6], (bfhi(x.w) - st.x) * st.y * lg[7] + lb[7]); }
              *(LAS u32x4*)(img + (c >> 2) * 8192 + row * 64 + (c & 3) * 16) = w; }
          const int gidx = lane >> 4, qp = (lane & 15) >> 2, pp = lane & 3;
          LAS const unsigned char* rp = img + (8 * (gidx >> 1) + qp) * 64 + (16 * (gidx & 1) + 4 * pp) * 2;
          const int ntt = nrows == 128 ? 4 : 1;
#pragma unroll
          for (int tt = 0; tt < 4; ++tt) { if (tt < ntt) {
              bf16x8_t bfr[8];
#pragma unroll
              for (int ks = 0; ks < 2 * tt + 2; ++ks) bfr[ks] = *(const bf16x8_t*)(wmb + (size_t)(32 * tt + t32) * 128 + 16 * ks + 8 * hi);
              const int t = 32 * tt + t32; const float bsv = bs_[g * 128 + (t < 128 ? t : 0)];
#pragma unroll
              for (int dhh = 0; dhh < 2; ++dhh) { f32x16 acc;
#pragma unroll
                  for (int j = 0; j < 16; ++j) acc[j] = 0.f;
#pragma unroll
                  for (int ks = 0; ks < 2 * tt + 2; ++ks) { const s16x4_t lo = vtr(rp + dhh * 8192 + ks * 1024), hi4 = vtr(rp + dhh * 8192 + ks * 1024 + 256);
                      const bf16x8_t af = (bf16x8_t){lo[0], lo[1], lo[2], lo[3], hi4[0], hi4[1], hi4[2], hi4[3]};
                      acc = __builtin_amdgcn_mfma_f32_32x32x16_bf16(af, bfr[ks], acc, 0, 0, 0); }
                  if (t < nrows) { const size_t m = (size_t)(m0 + t);
#pragma unroll
                      for (int j4 = 0; j4 < 4; ++j4) { const int dcol = col0 + dhh * 32 + 8 * j4 + 4 * hi;
                          const u32x2 uw = *(const u32x2*)(UZ + m * 1024 + dcol);
                          u32x2 o; o.x = pk2(bflo(uw.x) * (acc[4 * j4 + 0] + bsv), bfhi(uw.x) * (acc[4 * j4 + 1] + bsv)); o.y = pk2(bflo(uw.y) * (acc[4 * j4 + 2] + bsv), bfhi(uw.y) * (acc[4 * j4 + 3] + bsv));
                          *(u32x2*)(YA + m * 1536 + dcol) = o; } }
              } } }
      } }
    __syncthreads();
}
__device__ __forceinline__ void spatial_phase(const PT& a, int l, LAS unsigned char* lds, int tid, int bid, int G) {
    for (int it = bid; it < 256 + DBATCH; it += G) spatial_item(a, l, it, lds, tid);
}

__device__ __forceinline__ int crow(int j, int hi) { return (j & 3) + 8 * (j >> 2) + 4 * hi; }
__device__ __forceinline__ unsigned cvtpk(float lo, float hi) { unsigned r; asm volatile("v_cvt_pk_bf16_f32 %0, %1, %2" : "=v"(r) : "v"(lo), "v"(hi)); return r; }
constexpr float ATT_SCALE2 = 0.125f * 1.4426950408889634f;

__device__ __forceinline__ void attn_unit_lds(LAS const unsigned char* lds, int slot0  , int qt, const bf16x8_t (&qf)[4], bf16* Og, float* Lg, int lane) {
    const int q32 = lane & 31, hi = lane >> 5;
    f32x16 st[5];
#pragma unroll
    for (int ti = 0; ti < 5; ++ti) { const int kt = qt - 4 + ti;
        if (kt >= 0) { LAS const unsigned char* kb = lds + (slot0 + ti) * 4096 + q32 * 128; const int sw = (q32 >> 1) & 7; f32x16 acc;
#pragma unroll
            for (int j = 0; j < 16; ++j) acc[j] = 0.f;
#pragma unroll
            for (int ks = 0; ks < 4; ++ks) { const bf16x8_t kf = *(LAS const bf16x8_t*)(kb + (((2 * ks + hi) ^ sw) << 4)); acc = __builtin_amdgcn_mfma_f32_32x32x16_bf16(kf, qf[ks], acc, 0, 0, 0); }
#pragma unroll
            for (int j = 0; j < 16; ++j) { const int cr = crow(j, hi); bool valid = true;
                if (ti == 0) valid = cr >= q32;
                if (ti == 4) valid = cr <= q32;
                st[ti][j] = valid ? acc[j] * ATT_SCALE2 : -1e30f; }
        } else {
#pragma unroll
            for (int j = 0; j < 16; ++j) st[ti][j] = -1e30f; }
    }
    float mx = -1e30f;
#pragma unroll
    for (int ti = 0; ti < 5; ++ti)
#pragma unroll
        for (int j = 0; j < 16; ++j) mx = fmaxf(mx, st[ti][j]);
    mx = fmaxf(mx, __shfl_xor(mx, 32));
    float lsum = 0.f;
#pragma unroll
    for (int ti = 0; ti < 5; ++ti)
#pragma unroll
        for (int j = 0; j < 16; ++j) { st[ti][j] = __builtin_amdgcn_exp2f(st[ti][j] - mx); lsum += st[ti][j]; }
    lsum += __shfl_xor(lsum, 32);
    f32x16 o[2];
#pragma unroll
    for (int j = 0; j < 16; ++j) { o[0][j] = 0.f; o[1][j] = 0.f; }
    const int gidx = lane >> 4, qp = (lane & 15) >> 2, pp = lane & 3;
#pragma unroll
    for (int ti = 0; ti < 5; ++ti) { const int kt = qt - 4 + ti;
        if (kt >= 0) { LAS const unsigned char* img = lds + 65536 + (slot0 + ti) * 4096;
#pragma unroll
            for (int ks2 = 0; ks2 < 2; ++ks2) {
                u32x4 pw; pw.x = cvtpk(st[ti][8 * ks2 + 0], st[ti][8 * ks2 + 1]); pw.y = cvtpk(st[ti][8 * ks2 + 2], st[ti][8 * ks2 + 3]); pw.z = cvtpk(st[ti][8 * ks2 + 4], st[ti][8 * ks2 + 5]); pw.w = cvtpk(st[ti][8 * ks2 + 6], st[ti][8 * ks2 + 7]);
                const bf16x8_t pf = __builtin_bit_cast(bf16x8_t, pw);
                LAS const unsigned char* rp = img + (16 * ks2 + 4 * (gidx >> 1) + qp) * 64 + (16 * (gidx & 1) + 4 * pp) * 2;
#pragma unroll
                for (int dh = 0; dh < 2; ++dh) { const s16x4_t lo = vtr(rp + dh * 2048), hi4 = vtr(rp + dh * 2048 + 8 * 64);
                    const bf16x8_t vf = (bf16x8_t){lo[0], lo[1], lo[2], lo[3], hi4[0], hi4[1], hi4[2], hi4[3]};
                    o[dh] = __builtin_amdgcn_mfma_f32_32x32x16_bf16(vf, pf, o[dh], 0, 0, 0); } } }
    }
    const size_t qrow = (size_t)(32 * qt + q32);
    const float inv = 1.0f / lsum; bf16* op = Og + qrow * 64;
#pragma unroll
    for (int dh = 0; dh < 2; ++dh)
#pragma unroll
        for (int j4 = 0; j4 < 4; ++j4) { u32x2 w; w.x = cvtpk(o[dh][4 * j4 + 0] * inv, o[dh][4 * j4 + 1] * inv); w.y = cvtpk(o[dh][4 * j4 + 2] * inv, o[dh][4 * j4 + 3] * inv);
            *(u32x2*)(op + 32 * dh + 8 * j4 + 4 * hi) = w; }
    if (hi == 0) Lg[qrow] = (mx + __builtin_amdgcn_logf(lsum)) * 0.6931471805599453f;
}

template <int MODE  > __device__ __forceinline__ void attn_prompt_item(const PT& a, int item, LAS unsigned char* lds, int tid) {
    unsigned char* ws_ = a.ws(); const int wave = __builtin_amdgcn_readfirstlane(tid >> 6), lane = tid & 63, q32 = lane & 31, hi = lane >> 5;
    const int c2 = item & 1, h = (item >> 1) & 7, b = item >> 4;
    const bf16* QA = (const bf16*)(ws_ + WS_Q); const bf16* KA = (const bf16*)(ws_ + WS_K); const bf16* VA = (const bf16*)(ws_ + WS_V);
    int soff, doff;
    if (wave < 4) { const int rr = 8 * wave + (lane >> 3), sp = lane & 7; soff = rr * 64 + ((sp ^ ((rr >> 1) & 7)) << 3); doff = wave * 1024; }
    else { const int ci = wave - 4, dh = ci >> 1, kk = ci & 1; soff = (16 * kk + (lane >> 2)) * 64 + dh * 32 + (lane & 3) * 8; doff = 65536 + dh * 2048 + kk * 1024; }
    const bf16* src = wave < 4 ? KA : VA;
    if (MODE & 3) for (int o = 0; o < 12; ++o) {
        int g, n, r_w, qt_w, slot0;
        if (o < 4) { g = 0; n = 2048; r_w = 0; qt_w = 32 * c2 + 8 * o + wave; slot0 = wave; }
        else if (o < 8) { g = 1; n = 512; r_w = o - 4; qt_w = 8 * c2 + wave; slot0 = wave; }
        else { g = 2; n = 128; r_w = 4 * (o - 8) + (wave >> 1); qt_w = 2 * c2 + (wave & 1); slot0 = 4 * (wave >> 1) + qt_w - 4; }
        const size_t grow0 = (size_t)(b * 24 + g * 8 + h) * 2048;
        __syncthreads();
        if (MODE & 1) { if (g < 2) { const int qt0 = qt_w - wave; const size_t base = (grow0 + (size_t)r_w * n) * 64;
#pragma unroll
            for (int i = 0; i < 12; ++i) { const int kt = qt0 - 4 + i; if (kt >= 0)
                __builtin_amdgcn_global_load_lds((const unsigned*)(src + base + (size_t)kt * 2048 + soff), (LAS unsigned*)(lds + doff + i * 4096), 16, 0, 0); }
        } else { const int ktmax = 2 * c2 + 1;
#pragma unroll
            for (int i = 0; i < 16; ++i) { const int rr = i >> 2, kt = i & 3; if (kt <= ktmax)
                __builtin_amdgcn_global_load_lds((const unsigned*)(src + (grow0 + (size_t)(4 * (o - 8) + rr) * n + 32 * kt) * 64 + soff), (LAS unsigned*)(lds + doff + i * 4096), 16, 0, 0); }
        } }
        bf16x8_t qf[4]; { const bf16* qp = QA + (grow0 + (size_t)r_w * n + 32 * qt_w + q32) * 64 + 8 * hi;
#pragma unroll
            for (int ks = 0; ks < 4; ++ks) qf[ks] = *(const bf16x8_t*)(qp + 16 * ks); }
        asm volatile("s_waitcnt vmcnt(0)" ::: "memory");
        __syncthreads();
        const size_t orow0 = (size_t)((g * NBATCH + b) * 8 + h) * 2048 + (size_t)r_w * n;
        if (MODE & 2) attn_unit_lds(lds, slot0, qt_w, qf, (bf16*)(ws_ + (MODE == 7 ? WS_OG : WS_MERGED)) + orow0 * 64, (float*)(ws_ + (MODE == 7 ? WS_LSE : WS_MERGED)) + orow0, lane);
    }
    __syncthreads();
    if (MODE & 4) {
        const bf16* OG = (const bf16*)(ws_ + WS_OG); const float* LSE = (const float*)(ws_ + WS_LSE); const int c8 = tid & 7;
#pragma unroll 4
        for (int ps = 0; ps < 16; ++ps) { const int t = 1024 * c2 + 64 * ps + (tid >> 3);
            size_t ro[3];
#pragma unroll
            for (int g = 0; g < 3; ++g) ro[g] = (size_t)((g * NBATCH + b) * 8 + h) * 2048 + (size_t)(t & ((1 << (2 * g)) - 1)) * (2048 >> (2 * g)) + (t >> (2 * g));
            const float l0 = LSE[ro[0]], l1 = LSE[ro[1]], l2 = LSE[ro[2]];
            const u32x4 a0 = *(const u32x4*)(OG + ro[0] * 64 + 8 * c8), a1 = *(const u32x4*)(OG + ro[1] * 64 + 8 * c8), a2 = *(const u32x4*)(OG + ro[2] * 64 + 8 * c8);
            const u32x4 zb = *(const u32x4*)((const bf16*)(ws_ + WS_ZB) + ((size_t)b * SEQ + t) * 512 + h * 64 + 8 * c8);
            const float mx = fmaxf(l0, fmaxf(l1, l2)); float w0 = __expf(l0 - mx), w1 = __expf(l1 - mx), w2 = __expf(l2 - mx); const float inv = 1.0f / (w0 + w1 + w2); w0 *= inv; w1 *= inv; w2 *= inv;
            u32x4 ov;
            ov.x = pk2((w0 * bflo(a0.x) + w1 * bflo(a1.x) + w2 * bflo(a2.x)) * bflo(zb.x), (w0 * bfhi(a0.x) + w1 * bfhi(a1.x) + w2 * bfhi(a2.x)) * bfhi(zb.x));
            ov.y = pk2((w0 * bflo(a0.y) + w1 * bflo(a1.y) + w2 * bflo(a2.y)) * bflo(zb.y), (w0 * bfhi(a0.y) + w1 * bfhi(a1.y) + w2 * bfhi(a2.y)) * bfhi(zb.y));
            ov.z = pk2((w0 * bflo(a0.z) + w1 * bflo(a1.z) + w2 * bflo(a2.z)) * bflo(zb.z), (w0 * bfhi(a0.z) + w1 * bfhi(a1.z) + w2 * bfhi(a2.z)) * bfhi(zb.z));
            ov.w = pk2((w0 * bflo(a0.w) + w1 * bflo(a1.w) + w2 * bflo(a2.w)) * bflo(zb.w), (w0 * bfhi(a0.w) + w1 * bfhi(a1.w) + w2 * bfhi(a2.w)) * bfhi(zb.w));
            *(u32x4*)((bf16*)(ws_ + WS_Y) + ((size_t)b * SEQ + t) * 1536 + 1024 + h * 64 + 8 * c8) = ov; }
    }
}

__device__ __forceinline__ void attn_sample_item(const PT& a, int l, int item, LAS unsigned char* lds, int tid) {
    unsigned char* ws_ = a.ws(); const float* cache0_ = a.cache0(); const float* cache1_ = a.cache1(); const float* cache2_ = a.cache2();
    const int wave = __builtin_amdgcn_readfirstlane(tid >> 6), lane = tid & 63; const int b = item >> 3, t = item & 7; const int h = lane >> 3, ds = (lane & 7) * 8;
    const bf16* QA = (const bf16*)(ws_ + WS_Q) + QKV_S_OFF; const bf16* KA = (const bf16*)(ws_ + WS_K) + QKV_S_OFF; const bf16* VA = (const bf16*)(ws_ + WS_V) + QKV_S_OFF; const size_t m = (size_t)MP + item;
    LAS float* PO = (LAS float*)(lds + 65536); LAS float* PM = (LAS float*)(lds + 65536 + 49152); LAS float* PL = PM + 192;
    for (int g = 0; g < 3; ++g) { const int dil = g == 0 ? 1 : g == 1 ? 4 : 16, nprev = 128 * dil;
        const float* cache = (g == 0 ? cache0_ : g == 1 ? cache1_ : cache2_) + ((size_t)l * DBATCH + b) * nprev * 1024;
        float q[8]; { const u32x4 w = *(const u32x4*)(QA + (size_t)item * 1536 + g * 512 + h * 64 + ds);
            q[0] = bflo(w.x) * ATT_SCALE2; q[1] = bfhi(w.x) * ATT_SCALE2; q[2] = bflo(w.y) * ATT_SCALE2; q[3] = bfhi(w.y) * ATT_SCALE2; q[4] = bflo(w.z) * ATT_SCALE2; q[5] = bfhi(w.z) * ATT_SCALE2; q[6] = bflo(w.w) * ATT_SCALE2; q[7] = bfhi(w.w) * ATT_SCALE2; }
        float o[8];
#pragma unroll
        for (int i = 0; i < 8; ++i) o[i] = 0.f;
        float mx = -1e30f, lsum = 0.f;
        const int j0 = wave == 0 ? 0 : 16 * wave + 1, j1 = 16 * wave + 16;
        for (int jb = j0; jb <= j1; jb += 8) {
            float kf[8][8], vf[8][8];
#pragma unroll
            for (int u = 0; u < 8; ++u) { const int j = jb + u <= j1 ? jb + u : j1; const int idx = nprev + t - dil * j;
                if (idx >= nprev) { const size_t ko = (size_t)(b * 8 + (idx - nprev)) * 1536 + g * 512 + h * 64 + ds; const u32x4 kw = *(const u32x4*)(KA + ko), vw = *(const u32x4*)(VA + ko);
                    kf[u][0] = bflo(kw.x); kf[u][1] = bfhi(kw.x); kf[u][2] = bflo(kw.y); kf[u][3] = bfhi(kw.y); kf[u][4] = bflo(kw.z); kf[u][5] = bfhi(kw.z); kf[u][6] = bflo(kw.w); kf[u][7] = bfhi(kw.w);
                    vf[u][0] = bflo(vw.x); vf[u][1] = bfhi(vw.x); vf[u][2] = bflo(vw.y); vf[u][3] = bfhi(vw.y); vf[u][4] = bflo(vw.z); vf[u][5] = bfhi(vw.z); vf[u][6] = bflo(vw.w); vf[u][7] = bfhi(vw.w);
                } else { const float* kp = cache + (size_t)idx * 1024 + h * 64 + ds; const f32x4 k0 = *(const f32x4*)kp, k1 = *(const f32x4*)(kp + 4), v0 = *(const f32x4*)(kp + 512), v1 = *(const f32x4*)(kp + 516);
                    kf[u][0] = k0[0]; kf[u][1] = k0[1]; kf[u][2] = k0[2]; kf[u][3] = k0[3]; kf[u][4] = k1[0]; kf[u][5] = k1[1]; kf[u][6] = k1[2]; kf[u][7] = k1[3];
                    vf[u][0] = v0[0]; vf[u][1] = v0[1]; vf[u][2] = v0[2]; vf[u][3] = v0[3]; vf[u][4] = v1[0]; vf[u][5] = v1[1]; vf[u][6] = v1[2]; vf[u][7] = v1[3]; } }
#pragma unroll
            for (int u = 0; u < 8; ++u) { if (jb + u <= j1) {
                float s = 0.f;
#pragma unroll
                for (int i = 0; i < 8; ++i) s += q[i] * kf[u][i];
                s += __shfl_xor(s, 1); s += __shfl_xor(s, 2); s += __shfl_xor(s, 4);
                const float mn = fmaxf(mx, s), corr = __builtin_amdgcn_exp2f(mx - mn), p = __builtin_amdgcn_exp2f(s - mn); mx = mn; lsum = lsum * corr + p;
#pragma unroll
                for (int i = 0; i < 8; ++i) o[i] = o[i] * corr + p * vf[u][i]; } }
        }
        const int pi = g * 8 + wave;
        *(LAS f32x4*)(PO + pi * 512 + lane * 8) = (f32x4){o[0], o[1], o[2], o[3]}; *(LAS f32x4*)(PO + pi * 512 + lane * 8 + 4) = (f32x4){o[4], o[5], o[6], o[7]};
        if ((lane & 7) == 0) { PM[pi * 8 + h] = mx; PL[pi * 8 + h] = lsum; }
    }
    __syncthreads();
    { const int hh = tid >> 6; float M = -1e30f;
#pragma unroll
      for (int p = 0; p < 24; ++p) M = fmaxf(M, PM[p * 8 + hh]);
      float L = 0.f, acc = 0.f;
#pragma unroll
      for (int p = 0; p < 24; ++p) { const float w = __builtin_amdgcn_exp2f(PM[p * 8 + hh] - M); L += w * PL[p * 8 + hh]; acc += w * PO[p * 512 + tid]; }
      const float zb = bf2f(((const bf16*)(ws_ + WS_ZB))[m * 512 + tid]);
      ((bf16*)(ws_ + WS_Y))[m * 1536 + 1024 + tid] = (bf16)f2bf(acc / L * zb); }
    __syncthreads();
}

__device__ __forceinline__ void attn_phase(const PT& a, int l, LAS unsigned char* lds, int tid, int bid, int G) {
    for (int rep_ = 0; rep_ < (PROBE_DUP == 8 ? 2 : 1); ++rep_) for (int it = bid; it < MS; it += G) attn_sample_item(a, l, it, lds, tid);
    for (int it = bid; it < NBATCH * 8 * 2; it += G) attn_prompt_item<7>(a, it, lds, tid);
    if (PROBE_DUP >= 9 && PROBE_DUP <= 13) { __syncthreads(); for (int it = bid; it < NBATCH * 8 * 2; it += G) attn_prompt_item<PROBE_DUP == 9 ? 7 : PROBE_DUP == 10 ? 3 : PROBE_DUP == 11 ? 4 : PROBE_DUP == 12 ? 1 : 2>(a, it, lds, tid); }
}

#define XB_TMO      128
#define XB_XCNT(j)  (256  + 64 * (j))
#define XB_XSUB(j)  (1280 + 64 * (j))
#define XB_XGEN(j)  (2304 + 64 * (j))
#define XB_TOP      3328
#define XB_TOPGEN   3392
#define XCD_BAR_WORDS 3456
#define XB_SPIN_CAP (1u << 18)

__device__ __forceinline__ unsigned xb_ld(unsigned* p)              { return __hip_atomic_load(p, __ATOMIC_RELAXED, __HIP_MEMORY_SCOPE_AGENT); }
__device__ __forceinline__ unsigned xb_add(unsigned* p, unsigned v) { return __hip_atomic_fetch_add(p, v, __ATOMIC_RELAXED, __HIP_MEMORY_SCOPE_AGENT); }
__device__ __forceinline__ unsigned xb_xcc_id() { return (unsigned)__builtin_amdgcn_s_getreg((3 << 11) | 20) & 0xFu; }
#define XB_SPIN(cond, bar) do { unsigned _sp = 0; while (cond) { __builtin_amdgcn_s_sleep(1); \
    if ((++_sp & 255u) == 0u) { if (xb_ld(&(bar)[XB_TMO])) break; if (_sp > XB_SPIN_CAP) { atomicAdd(&(bar)[XB_TMO], 1u); break; } } } } while (0)

struct XcdBarrier {
    unsigned* bar; unsigned x;
    volatile LAS unsigned* st;
};

__device__ __forceinline__ XcdBarrier xcd_barrier_post(unsigned* bar, volatile LAS unsigned* st) {
    XcdBarrier b; b.bar = bar; b.x = xb_xcc_id(); b.st = st;
    if (threadIdx.x == 0) (void)xb_add(&bar[XB_XCNT(b.x)], 1u);
    return b;
}
__device__ __forceinline__ void xcd_barrier_complete(unsigned* bar, unsigned x, unsigned& nloc, unsigned& nx) {
    const unsigned G = gridDim.x * gridDim.y * gridDim.z;
    unsigned sum, cnt, mine, sp = 0u;
    for (;;) {
        sum = 0u; cnt = 0u; mine = 0u;
#pragma unroll
        for (unsigned j = 0; j < 16; ++j) { const unsigned c = xb_ld(&bar[XB_XCNT(j)]); sum += c; cnt += (c > 0u) ? 1u : 0u; mine = (j == x) ? c : mine; }
        if (sum == G) break;
        __builtin_amdgcn_s_sleep(1);
        if ((++sp & 255u) == 0u) { if (xb_ld(&bar[XB_TMO])) break; if (sp > XB_SPIN_CAP) { atomicAdd(&bar[XB_TMO], 1u); break; } }
    }
    nloc = mine > 0u ? mine : 1u; nx = cnt > 0u ? cnt : 1u;
}

__device__ __forceinline__ void xcd_barrier(const XcdBarrier& b) {
    asm volatile("s_waitcnt vmcnt(0)" ::: "memory");
    __syncthreads();
    if (threadIdx.x == 0) {
        unsigned* bar = b.bar;
        __builtin_amdgcn_s_waitcnt(0);
        unsigned nloc = b.st[0], nx = b.st[1];
        if (nloc == 0u) { xcd_barrier_complete(bar, b.x, nloc, nx); b.st[0] = nloc; b.st[1] = nx; }
        const unsigned old = xb_add(&bar[XB_XSUB(b.x)], 1u);
        const unsigned gen = old / nloc;
        if (old + 1u == (gen + 1u) * nloc) {
            __builtin_amdgcn_fence(__ATOMIC_RELEASE, "agent");
            asm volatile("s_waitcnt vmcnt(0)" ::: "memory");
            const unsigned og = xb_add(&bar[XB_TOP], 1u);
            const unsigned tg = og / nx;
            if (og + 1u == (tg + 1u) * nx) xb_add(&bar[XB_TOPGEN], 1u);
            else XB_SPIN(xb_ld(&bar[XB_TOPGEN]) == tg, bar);
            __builtin_amdgcn_fence(__ATOMIC_ACQUIRE, "agent");
            xb_add(&bar[XB_XGEN(b.x)], 1u);
            asm volatile("s_waitcnt vmcnt(0)" ::: "memory");
        } else {
            XB_SPIN(xb_ld(&bar[XB_XGEN(b.x)]) == gen, bar);
            __builtin_amdgcn_fence(__ATOMIC_ACQUIRE, "agent");
            asm volatile("s_waitcnt vmcnt(0)" ::: "memory");
        }
    }
    __syncthreads();
}

#define GSYNC() do { XcdBarrier xb_; xb_.bar = (unsigned*)a.ws(); xb_.x = xb_xcc_id(); xb_.st = (volatile LAS unsigned*)(lds + PTAB_OFF + 256); xcd_barrier(xb_); if (PROBE_DUP == 14) xcd_barrier(xb_); } while (0)
#define REP(k) for (int rep_ = 0; rep_ < ((PROBE_DUP == (k)) ? 2 : 1); ++rep_)

__global__ void __launch_bounds__(NTHREADS, 2) hybrid_step_fwd(Args ka) {
    extern __shared__ __attribute__((aligned(16))) unsigned char lds_raw[];
    LAS unsigned char* lds = (LAS unsigned char*)lds_raw;
    cg::grid_group grid = cg::this_grid();
    const int bid = blockIdx.x, G = gridDim.x;
    { LAS unsigned long long* pt = (LAS unsigned long long*)(lds + PTAB_OFF);
      if (threadIdx.x == 0) { pt[0] = (unsigned long long)ka.x_prompt; pt[1] = (unsigned long long)ka.x_sample; pt[2] = (unsigned long long)ka.cache0; pt[3] = (unsigned long long)ka.cache1; pt[4] = (unsigned long long)ka.cache2;
          pt[5] = (unsigned long long)ka.c_prompt; pt[6] = (unsigned long long)ka.c_sample; pt[7] = (unsigned long long)ka.w_ada; pt[8] = (unsigned long long)ka.b_ada; pt[9] = (unsigned long long)ka.norm_g;
          pt[10] = (unsigned long long)ka.w_in; pt[11] = (unsigned long long)ka.gm_ln_g; pt[12] = (unsigned long long)ka.gm_ln_b; pt[13] = (unsigned long long)ka.gm_ws; pt[14] = (unsigned long long)ka.gm_bs;
          pt[32] = 0ull;
          pt[15] = (unsigned long long)ka.w_gm_out; pt[16] = (unsigned long long)ka.w_att_out; pt[17] = (unsigned long long)ka.w_o; pt[18] = (unsigned long long)ka.final_g; pt[19] = (unsigned long long)ka.out; pt[20] = (unsigned long long)ka.ws; }
      __syncthreads(); }
    PT a; a.t = (LAS const unsigned long long*)(lds + PTAB_OFF);
    (void)xcd_barrier_post((unsigned*)ka.ws, (volatile LAS unsigned*)(lds + PTAB_OFF + 256));
#define TID() ({ int t_ = threadIdx.x; asm volatile("" : "+v"(t_)); t_; })
#define WSP(T, off) ((T*)(a.ws() + (off)))

    REP(6) { p0_phase(a, lds, TID(), bid, G); __syncthreads(); }
    grid.sync();
    REP(7) norm_phase(a, 0, nullptr, TID(), bid, G);
    GSYNC();
    for (int l = 0; l < 2; ++l) {
        REP(1) { pg8::Gemm g{WSP(bf16, WS_H), WSP(bf16, WS_WTIN) + (size_t)l * NPROJ * 1024, MROWS, NPROJ, 1024}; pg8::StaticOrder S; S.init(MROWS, NPROJ, G, bid);
          pg8::EpiProj E{a.ws(), a.out(), l}; pg8::gemm_phase<pg8::EpiProj, pg8::StaticOrder, true, true>(lds, g, S, E); }
        GSYNC();
        REP(2) spatial_phase(a, l, lds, TID(), bid, G);
        REP(3) attn_phase(a, l, lds, TID(), bid, G);
        GSYNC();
        REP(4) { pg8::Gemm g{WSP(bf16, WS_Y), WSP(bf16, WS_WTCAT) + (size_t)l * 1024 * 1536, MROWS, 1024, 1536}; pg8::StaticOrder S; S.init(MROWS, 1024, G, bid);
          pg8::EpiMerge E{WSP(bf16, WS_SGA), WSP(bf16, WS_SGB), WSP(bf16, WS_MERGED)}; pg8::gemm_phase<pg8::EpiMerge, pg8::StaticOrder, true, true, 16>(lds, g, S, E); }
        GSYNC();
        for (int rep_ = 0; rep_ < ((PROBE_DUP == 5 && l == 0) ? 2 : 1); ++rep_) { pg8::Gemm g{WSP(bf16, WS_MERGED), WSP(bf16, WS_WTO) + (size_t)l * 1024 * 1024, MROWS, 1024, 1024}; pg8::StaticOrder S; S.init(MROWS, 1024, G, bid);
          float* XB = WSP(float, WS_X);
          pg8::EpiResid E{l == 0 ? a.x_prompt() : XB, l == 0 ? a.x_sample() : XB + (size_t)MP * 1024, WSP(float, WS_MOD) + (size_t)l * NCOND * 3072 + 2048, XB};
          pg8::gemm_phase<pg8::EpiResid, pg8::StaticOrder, true, true>(lds, g, S, E); }
        GSYNC();
        REP(7) norm_phase(a, l + 1, WSP(float, WS_X), TID(), bid, G);
        if (l == 0) GSYNC();
    }
}

extern "C" void kernel_launch(void* const* d_in, const int* in_sizes, int n_in, void* d_out, int out_size, void* d_ws, size_t ws_size, hipStream_t stream) {
    static int grid = 0;
    if (grid == 0) {
        if (n_in != 19 || (size_t)out_size != O_TOTAL || ws_size < WS_END) { fprintf(stderr, "kernel_launch: unexpected sizes: n_in %d out %d (want %zu) ws %zu (want >= %zu)\n", n_in, out_size, (size_t)O_TOTAL, ws_size, (size_t)WS_END); grid = -1; return; }
        int dev = 0, cus = 0, per_cu = 0;
        hipGetDevice(&dev); hipDeviceGetAttribute(&cus, hipDeviceAttributeMultiprocessorCount, dev);
        if (hipFuncSetAttribute((const void*)hybrid_step_fwd, hipFuncAttributeMaxDynamicSharedMemorySize, LDS_BYTES) != hipSuccess) { fprintf(stderr, "kernel_launch: hipFuncSetAttribute failed\n"); grid = -1; return; }
        if (hipOccupancyMaxActiveBlocksPerMultiprocessor(&per_cu, (const void*)hybrid_step_fwd, NTHREADS, LDS_BYTES) != hipSuccess || per_cu < 1) { fprintf(stderr, "kernel_launch: occupancy query failed (%d)\n", per_cu); (void)hipGetLastError(); grid = -1; return; }
        grid = cus * per_cu;
        fprintf(stderr, "kernel_launch: %d CUs x %d blocks/CU -> grid %d\n", cus, per_cu, grid);
    }
    if (grid < 0) return;
    Args a{};
    a.x_prompt = (const float*)d_in[0]; a.x_sample = (const float*)d_in[1]; a.cache0 = (const float*)d_in[2]; a.cache1 = (const float*)d_in[3]; a.cache2 = (const float*)d_in[4];
    a.c_prompt = (const float*)d_in[5]; a.c_sample = (const float*)d_in[6]; a.w_ada = (const float*)d_in[7]; a.b_ada = (const float*)d_in[8]; a.norm_g = (const float*)d_in[9];
    a.w_in = (const float*)d_in[10]; a.gm_ln_g = (const float*)d_in[11]; a.gm_ln_b = (const float*)d_in[12]; a.gm_ws = (const float*)d_in[13]; a.gm_bs = (const float*)d_in[14];
    a.w_gm_out = (const float*)d_in[15]; a.w_att_out = (const float*)d_in[16]; a.w_o = (const float*)d_in[17]; a.final_g = (const float*)d_in[18];
    a.out = (float*)d_out; a.ws = (unsigned char*)d_ws;
    if (hipMemsetAsync(d_ws, 0, 16384, stream) != hipSuccess) { fprintf(stderr, "kernel_launch: hipMemsetAsync failed\n"); return; }
    void* args[] = {&a};
    hipError_t e = hipLaunchCooperativeKernel((const void*)hybrid_step_fwd, dim3(grid), dim3(NTHREADS), args, LDS_BYTES, stream);
    if (e != hipSuccess) fprintf(stderr, "kernel_launch: cooperative launch failed: %s (grid %d)\n", hipGetErrorString(e), grid);
}
```
